# Optimizing an MI355X kernel written in HIP

```python
import jax, jax.numpy as jnp
from jax import lax
import numpy as np

D_MODEL = 1024
BATCH = 8
SEQ = 2048
DEPTH = 1

HEAD_DIM = 64
N_SLOT_HEADS = 8
DILATED_PATTERNS = ((128, 1), (512, 4), (2048, 16))
N_GROUPS = len(DILATED_PATTERNS)
ATTN_HEADS = N_GROUPS * N_SLOT_HEADS
ATTN_QKV_WIDTH = ATTN_HEADS * HEAD_DIM
ATTN_OUT_WIDTH = N_SLOT_HEADS * HEAD_DIM
BLK = max(w // (2 * d) for (w, d) in DILATED_PATTERNS)
ROPE_THETA = 500000.0
ROT_DIM = HEAD_DIM // 4
CONV_CH = D_MODEL // 2
CONV_WIDTH = 31
N_BRANCH = 2
D_FF = -(-8 * D_MODEL // 768) * 256
IN_WIDTH = 3 * ATTN_QKV_WIDTH + 2 * CONV_CH + N_BRANCH * D_MODEL
EPS = 1e-6
NEG_INF = -1e30

kernel_name = 'hybrid_dilated_attn_conformer_conv_block'


def rmsnorm(t, w):
    tf = t.astype(jnp.float32)
    y = tf * lax.rsqrt(jnp.mean(tf * tf, axis=-1, keepdims=True) + EPS)
    return (y * w.astype(jnp.float32)).astype(t.dtype)


def layernorm(t, w, b):
    tf = t.astype(jnp.float32)
    mu = jnp.mean(tf, axis=-1, keepdims=True)
    var = jnp.mean(jnp.square(tf - mu), axis=-1, keepdims=True)
    y = (tf - mu) * lax.rsqrt(var + EPS)
    return (y * w.astype(jnp.float32) + b.astype(jnp.float32)).astype(t.dtype)


def partial_rope(t, cos, sin):
    tf = t.astype(jnp.float32)
    half = ROT_DIM // 2
    t1, t2, rest = tf[..., :half], tf[..., half:ROT_DIM], tf[..., ROT_DIM:]
    rot = jnp.concatenate([t1 * cos - t2 * sin, t2 * cos + t1 * sin, rest], axis=-1)
    return rot.astype(t.dtype)


def dilated_window_attention(q, k, v, dilation, half_span):
    B, S, H, Dh = q.shape
    L = S // dilation
    nb = -(-L // BLK)
    Lp = nb * BLK

    def residue_major(t):
        return t.reshape(B, L, dilation, H, Dh).transpose(0, 2, 3, 1, 4)

    qr, kr, vr = residue_major(q), residue_major(k), residue_major(v)
    qb = jnp.pad(qr, [(0, 0)] * 3 + [(0, Lp - L), (0, 0)]).reshape(B, dilation, H, nb, BLK, Dh)

    def banded(t):
        tb = jnp.pad(t, [(0, 0)] * 3 + [(BLK, Lp - L + BLK), (0, 0)])
        tb = tb.reshape(B, dilation, H, nb + 2, BLK, Dh)
        return jnp.concatenate([tb[:, :, :, j:j + nb] for j in range(3)], axis=4)

    kb, vb = banded(kr), banded(vr)
    qpos = jnp.arange(nb)[:, None] * BLK + jnp.arange(BLK)[None, :]
    kpos = jnp.arange(nb)[:, None] * BLK - BLK + jnp.arange(3 * BLK)[None, :]
    dist = jnp.abs(qpos[:, :, None] - kpos[:, None, :])
    valid = (dist <= half_span) & (kpos[:, None, :] >= 0) & (kpos[:, None, :] < L)

    s = jnp.einsum('bdhnqc,bdhnkc->bdhnqk', qb.astype(jnp.float32), kb.astype(jnp.float32))
    s = jnp.where(valid, s * (HEAD_DIM ** -0.5), NEG_INF)
    m = jnp.max(s, axis=-1, keepdims=True)
    p = jnp.exp(s - m)
    den = jnp.sum(p, axis=-1, keepdims=True)
    o = jnp.einsum('bdhnqk,bdhnkc->bdhnqc', p, vb.astype(jnp.float32)) / den
    lse = (m + jnp.log(den))[..., 0]
    o = o.reshape(B, dilation, H, Lp, Dh)[:, :, :, :L].transpose(0, 3, 1, 2, 4).reshape(B, S, H, Dh)
    lse = lse.reshape(B, dilation, H, Lp)[..., :L].transpose(0, 3, 1, 2).reshape(B, S, H)
    return o, lse


def depthwise_conv(u, w, b):
    pad = (CONV_WIDTH - 1) // 2
    y = lax.conv_general_dilated(
        u, w[:, None, :].astype(u.dtype), window_strides=(1,), padding=[(pad, pad)],
        dimension_numbers=('NWC', 'WIO', 'NWC'), feature_group_count=CONV_CH)
    return y + b.astype(u.dtype)


def setup_inputs(seed: int = 0) -> dict:
    key = jax.random.key(seed)
    ks = jax.random.split(key, 20)
    f32 = jnp.float32

    def nrm(k, shape, scale):
        return jax.random.normal(k, shape, f32) * scale

    x = jax.random.normal(ks[0], (BATCH, SEQ, D_MODEL), f32)
    offsets = jax.random.randint(ks[1], (BATCH, 1), 0, 4096, dtype=jnp.int32)
    positions = (offsets + jnp.arange(SEQ, dtype=jnp.int32)[None, :]).astype(jnp.int32)
    return {
        'x': x,
        'positions': positions,
        'norm1_w': 1.0 + nrm(ks[2], (DEPTH, D_MODEL), 0.02),
        'w_in': nrm(ks[3], (DEPTH, D_MODEL, IN_WIDTH), D_MODEL ** -0.5),
        'b_gate': nrm(ks[4], (DEPTH, N_BRANCH, D_MODEL), 0.02),
        'q_norm_w': 1.0 + nrm(ks[5], (DEPTH, HEAD_DIM), 0.02),
        'k_norm_w': 1.0 + nrm(ks[6], (DEPTH, HEAD_DIM), 0.02),
        'w_o_attn': nrm(ks[7], (DEPTH, ATTN_OUT_WIDTH, D_MODEL), ATTN_OUT_WIDTH ** -0.5),
        'conv_w': nrm(ks[8], (DEPTH, CONV_WIDTH, CONV_CH), CONV_WIDTH ** -0.5),
        'conv_b': nrm(ks[9], (DEPTH, CONV_CH), 0.02),
        'conv_ln_w': 1.0 + nrm(ks[10], (DEPTH, CONV_CH), 0.02),
        'conv_ln_b': nrm(ks[11], (DEPTH, CONV_CH), 0.02),
        'w_pw_conv': nrm(ks[12], (DEPTH, CONV_CH, D_MODEL), CONV_CH ** -0.5),
        'w_out': nrm(ks[13], (DEPTH, D_MODEL, D_MODEL), D_MODEL ** -0.5),
        'norm2_w': 1.0 + nrm(ks[14], (DEPTH, D_MODEL), 0.02),
        'w_ffn_in': nrm(ks[15], (DEPTH, D_MODEL, 2 * D_FF), D_MODEL ** -0.5),
        'w_ffn_out': nrm(ks[16], (DEPTH, D_FF, D_MODEL), D_FF ** -0.5),
    }


def reference(x, positions, norm1_w, w_in, b_gate, q_norm_w, k_norm_w, w_o_attn,
              conv_w, conv_b, conv_ln_w, conv_ln_b, w_pw_conv, w_out, norm2_w,
              w_ffn_in, w_ffn_out):
    B, S, _ = x.shape
    inv_freq = ROPE_THETA ** (-jnp.arange(0, ROT_DIM, 2, dtype=jnp.float32) / ROT_DIM)
    ang = positions.astype(jnp.float32)[..., None] * inv_freq
    cos = jnp.cos(ang)[:, :, None, None, :]
    sin = jnp.sin(ang)[:, :, None, None, :]
    split_at = [ATTN_QKV_WIDTH, 2 * ATTN_QKV_WIDTH, 3 * ATTN_QKV_WIDTH,
                3 * ATTN_QKV_WIDTH + 2 * CONV_CH]

    for l in range(DEPTH):
        h = rmsnorm(x, norm1_w[l])
        proj = h @ w_in[l].astype(h.dtype)
        q, k, v, conv_in, gate_logits = jnp.split(proj, split_at, axis=-1)
        hshape = (B, S, N_GROUPS, N_SLOT_HEADS, HEAD_DIM)
        q = partial_rope(rmsnorm(q.reshape(hshape), q_norm_w[l]), cos, sin)
        k = partial_rope(rmsnorm(k.reshape(hshape), k_norm_w[l]), cos, sin)
        v = v.reshape(hshape)

        outs, lses = [], []
        for g, (window, dilation) in enumerate(DILATED_PATTERNS):
            o_g, lse_g = dilated_window_attention(q[:, :, g], k[:, :, g], v[:, :, g],
                                                  dilation, window // (2 * dilation))
            outs.append(o_g)
            lses.append(lse_g)
        mix = jax.nn.softmax(jnp.stack(lses, axis=0), axis=0)
        attn = jnp.sum(mix[..., None] * jnp.stack(outs, axis=0), axis=0)
        attn = attn.reshape(B, S, ATTN_OUT_WIDTH).astype(x.dtype)
        y_a = attn @ w_o_attn[l].astype(x.dtype)

        a, b = jnp.split(conv_in, 2, axis=-1)
        u = a * jax.nn.sigmoid(b)
        u = depthwise_conv(u, conv_w[l], conv_b[l])
        u = jax.nn.silu(layernorm(u, conv_ln_w[l], conv_ln_b[l]))
        y_b = u @ w_pw_conv[l].astype(u.dtype)

        gates = jax.nn.sigmoid(gate_logits + b_gate[l].reshape(N_BRANCH * D_MODEL).astype(x.dtype))
        g_a, g_b = jnp.split(gates, 2, axis=-1)
        x = x + (g_a * y_a + g_b * y_b) @ w_out[l].astype(x.dtype)

        h2 = rmsnorm(x, norm2_w[l])
        gt, up = jnp.split(h2 @ w_ffn_in[l].astype(h2.dtype), 2, axis=-1)
        x = x + (jax.nn.silu(gt) * up) @ w_ffn_out[l].astype(x.dtype)
    return x
```

```cpp
#include <hip/hip_runtime.h>
#include <hip/hip_cooperative_groups.h>
#include <cstdio>
#include <cstdint>
namespace cg = cooperative_groups;

#define LAS __attribute__((address_space(3)))
#define GAS __attribute__((address_space(1)))
typedef unsigned short bf16_t;
typedef short bf16x8 __attribute__((ext_vector_type(8)));
typedef short s16x4 __attribute__((ext_vector_type(4)));
typedef float f32x4 __attribute__((ext_vector_type(4)));
typedef float f32x2 __attribute__((ext_vector_type(2)));
typedef float f32x16 __attribute__((ext_vector_type(16)));
typedef unsigned u32x4 __attribute__((ext_vector_type(4)));
typedef unsigned u32x2 __attribute__((ext_vector_type(2)));
typedef __bf16 bf16x2_t __attribute__((ext_vector_type(2)));

constexpr int BATCH = 8, SEQ = 2048, DM = 1024, MTOK = BATCH * SEQ;
constexpr int NIN = 7680, DFF = 2816, NF1 = 2 * DFF;
constexpr int NGRP = 3, NHEAD = 8, HD = 64, QKVW = 1536, CCH = 512, CW = 31;
constexpr float EPS = 1e-6f;
constexpr float LOG2E = 1.4426950408889634f;
constexpr float QSCALE = 0.125f * LOG2E;

constexpr size_t MiB = 1u << 20;
constexpr size_t WS_CTL = 0, CTL_BYTES = 64 * 1024;
constexpr size_t WS_WIN = 1 * MiB;
constexpr size_t WS_WCAT = 16 * MiB;
constexpr size_t WS_WOUT = 18 * MiB;
constexpr size_t WS_WF1 = 20 * MiB;
constexpr size_t WS_WF2 = 31 * MiB;
constexpr size_t WS_SSQ = 37 * MiB;
constexpr size_t WS_ROPE = 38 * MiB;
constexpr size_t WS_Q = 40 * MiB;
constexpr size_t WS_K = 88 * MiB;
constexpr size_t WS_V = 136 * MiB;
constexpr size_t WS_GATE = 184 * MiB;
constexpr size_t WS_T = 40 * MiB;
constexpr size_t WS_Z = 104 * MiB;
constexpr size_t WS_X1B = 40 * MiB;
constexpr size_t WS_ACT = 72 * MiB;
constexpr size_t WS_END = 248 * MiB;
constexpr size_t DO_H = 0;
constexpr size_t DO_U = 32 * MiB;
constexpr size_t DO_AU = 0;

constexpr int LDS_MISC = 0, LDS_SCR = 1024, LDS_BYTES = 1024 + 139264;

__device__ __forceinline__ unsigned cvtpk(float lo, float hi) { f32x2 v = {lo, hi}; bf16x2_t b = __builtin_convertvector(v, bf16x2_t); return __builtin_bit_cast(unsigned, b); }
__device__ __forceinline__ float bf_lo(unsigned w) { return __uint_as_float(w << 16); }
__device__ __forceinline__ float bf_hi(unsigned w) { return __uint_as_float(w & 0xffff0000u); }
__device__ __forceinline__ float sigmoidf_(float x) { return __builtin_amdgcn_rcpf(1.0f + __builtin_amdgcn_exp2f(-x * LOG2E)); }
__device__ __forceinline__ float wave_sum(float v) {
#pragma unroll
    for (int o = 1; o < 64; o <<= 1) v += __shfl_xor(v, o);
    return v;
}
#define LDS_WAIT() asm volatile("s_waitcnt lgkmcnt(0)" ::: "memory")
#define VM_WAIT() asm volatile("s_waitcnt vmcnt(0)" ::: "memory")

__host__ __device__ __forceinline__ int pos2dim(int p) { return p < 16 ? (4 * (p >> 3) + 8 * ((p >> 2) & 1) + (p & 3)) : p; }
__host__ __device__ __forceinline__ int perm32(int rho) { const int n = rho >> 4, i = rho & 15; return 8 * (i >> 2) + 4 * n + (i & 3); }

namespace pg8 {
constexpr int BM = 256, BK = 64, HALF = 128, HTB = HALF * BK * 2, STAGE_BYTES = 8 * HTB, NXCD = 8, WGM = 8;
__host__ __device__ __forceinline__ int lds_byte(int r, int c) { const int st = (r >> 4) * 2 + (c >> 5), rr = r & 15, cc = c & 31, ob = rr * 64 + cc * 2; return st * 1024 + (ob ^ (((ob >> 9) & 1) << 5)); }
__host__ __device__ __forceinline__ void stage_rc(int b, int& R, int& C) { const int st = b / 1024, sb = b % 1024, swz = sb ^ (((sb >> 9) & 1) << 5); R = (st >> 1) * 16 + swz / 64; C = (st & 1) * 32 + (swz % 64) / 2; }

struct Unit { int pm, pn, kind; };
struct Gemm { const bf16_t* A; const bf16_t* Bt; int lda, ldb, K, koff; };

struct StaticOrder {
    int nM, nN, nwg, G, c, nkind;
    __device__ void init(int M, int N, int G_, int c_, int nkind_ = 1) { nM = M / BM; nN = N / BM; nwg = nM * nN; G = G_; c = c_; nkind = nkind_; }
    __device__ bool tile(long L, Unit& u) const {
        if (L >= nwg) return false;
        int wgid = (int)L; { const int q = nwg / NXCD, r = nwg % NXCD, xcd = wgid % NXCD, off = wgid / NXCD; wgid = (xcd < r ? xcd * (q + 1) : r * (q + 1) + (xcd - r) * q) + off; }
        const int nig = WGM * nN, gid = wgid / nig, fm = gid * WGM, gsz = (nM - fm) < WGM ? (nM - fm) : WGM;
        u.pm = fm + ((wgid % nig) % gsz); u.pn = (wgid % nig) / gsz; return true;
    }
    __device__ bool next(int i, Unit& u) const {
        if (nkind == 1) { u.kind = 0; return tile((long)i * G + c, u); }
        u.kind = i & 1; return tile((long)(i >> 1) * G + c, u);
    }
};

template <class Epi, class Sched>
__device__ __forceinline__ void gemm_phase(LAS unsigned char* lds, const Gemm g, const Sched& S, const Epi& E) {
    int tid = threadIdx.x; asm volatile("" : "+v"(tid));
    const int wid = __builtin_amdgcn_readfirstlane(tid >> 6), lane = tid & 63, wr = wid >> 2, wc = wid & 3, fr = lane & 15, fq = lane >> 4;
    const int nt = g.K / BK;
    unsigned voffA[2], voffB[2];
#pragma unroll
    for (int i = 0; i < 2; ++i) { int R, C; stage_rc(tid * 16 + i * 8192, R, C); voffA[i] = (unsigned)(R * g.lda + C) * 2u; voffB[i] = (unsigned)(R * g.ldb + C) * 2u; }
    const size_t kstep = (size_t)(BK * 2);
    const size_t hstepA = (size_t)HALF * g.lda * 2, hstepB = (size_t)HALF * g.ldb * 2;
    const size_t tstepA = 2 * hstepA, tstepB = 2 * hstepB;
    const unsigned ldsw = (unsigned)wid * 1024u;
    const int aoff = lds_byte(wr * 64 + fr, fq * 8), boff = lds_byte(wc * 32 + fr, fq * 8);
#define PG8_SA(b, h) (((b) * 2 + (h)) * HTB)
#define PG8_SB(b, h) ((4 + (b) * 2 + (h)) * HTB)
#define PG8_STAGE(bufoff, gbase, voff) do { _Pragma("unroll") for (int _i = 0; _i < 2; ++_i) \
        __builtin_amdgcn_global_load_lds((const unsigned*)((const char*)(gbase) + (voff)[_i]), (LAS unsigned*)(lds + (bufoff) + ldsw + _i * 8192), 16, 0, 0); } while (0)
#define PG8_LDA(dst, b, h) do { _Pragma("unroll") for (int m = 0; m < 4; ++m) _Pragma("unroll") for (int k = 0; k < 2; ++k) dst[m][k] = *(const LAS bf16x8*)(lds + PG8_SA(b, h) + aoff + m * 2048 + k * 1024); } while (0)
#define PG8_LDB(dst, b, h) do { _Pragma("unroll") for (int n = 0; n < 2; ++n) _Pragma("unroll") for (int k = 0; k < 2; ++k) dst[n][k] = *(const LAS bf16x8*)(lds + PG8_SB(b, h) + boff + n * 2048 + k * 1024); } while (0)
#define PG8_MMA(ai, bj, At, Bt) do { __builtin_amdgcn_s_setprio(1); _Pragma("unroll") for (int m = 0; m < 4; ++m) _Pragma("unroll") for (int n = 0; n < 2; ++n) _Pragma("unroll") for (int k = 0; k < 2; ++k) \
        acc[ai][bj][m][n] = __builtin_amdgcn_mfma_f32_16x16x32_bf16(Bt[n][k], At[m][k], acc[ai][bj][m][n], 0, 0, 0); __builtin_amdgcn_s_setprio(0); } while (0)
#define PG8_WAIT_V(n) asm volatile("s_waitcnt vmcnt(" #n ")" ::: "memory")
#define PG8_WAIT_L(n) asm volatile("s_waitcnt lgkmcnt(" #n ")" ::: "memory")
#define PG8_BAR __builtin_amdgcn_s_barrier()
#define PG8_SCHED __builtin_amdgcn_sched_barrier(0)
    Unit cur, nxt; int ui = 0;
    if (!S.next(0, cur)) return;
    f32x4 acc[2][2][4][2];
#pragma unroll
    for (int a = 0; a < 2; ++a)
#pragma unroll
        for (int b = 0; b < 2; ++b)
#pragma unroll
            for (int m = 0; m < 4; ++m)
#pragma unroll
                for (int n = 0; n < 2; ++n) acc[a][b][m][n] = (f32x4){0.f, 0.f, 0.f, 0.f};
    bf16x8 At[4][2], B0[2][2], B1[2][2];
    const char* cA = (const char*)g.A + (size_t)cur.pm * tstepA + (size_t)cur.kind * g.koff * 2;
    const char* cB = (const char*)g.Bt + (size_t)cur.pn * tstepB + (size_t)cur.kind * g.koff * 2;
    PG8_STAGE(PG8_SB(0, 0), cB, voffB); PG8_STAGE(PG8_SB(0, 1), cB + hstepB, voffB); PG8_STAGE(PG8_SA(0, 0), cA, voffA); PG8_STAGE(PG8_SA(0, 1), cA + hstepA, voffA);
    if (wr == 1) PG8_BAR;
    PG8_WAIT_V(2); PG8_BAR;
    PG8_STAGE(PG8_SB(1, 0), cB + kstep, voffB); PG8_STAGE(PG8_SA(1, 0), cA + kstep, voffA); PG8_STAGE(PG8_SB(1, 1), cB + hstepB + kstep, voffB);
    PG8_WAIT_V(6); PG8_BAR;
    for (;;) {
        const bool has_next = S.next(ui + 1, nxt);
        const char* nA = has_next ? (const char*)g.A + (size_t)nxt.pm * tstepA + (size_t)nxt.kind * g.koff * 2 : cA;
        const char* nB = has_next ? (const char*)g.Bt + (size_t)nxt.pn * tstepB + (size_t)nxt.kind * g.koff * 2 : cB;
        for (int t = 0; t < nt; t += 2) {
            const bool last = (t == nt - 2);
            const char* a1 = cA + (size_t)(t + 1) * kstep;
            const char* a2 = last ? nA : cA + (size_t)(t + 2) * kstep; const char* b2 = last ? nB : cB + (size_t)(t + 2) * kstep;
            const char* a3 = a2 + kstep; const char* b3 = b2 + kstep;
            PG8_LDB(B0, 0, 0); PG8_LDB(B1, 0, 1); PG8_SCHED; PG8_LDA(At, 0, 0); PG8_STAGE(PG8_SA(1, 1), a1 + hstepA, voffA);
            PG8_WAIT_V(8); PG8_WAIT_L(0); PG8_BAR; PG8_MMA(0, 0, At, B0); PG8_MMA(0, 1, At, B1); PG8_BAR; PG8_SCHED;
            PG8_LDA(At, 0, 1); PG8_STAGE(PG8_SB(0, 0), b2, voffB); PG8_STAGE(PG8_SB(0, 1), b2 + hstepB, voffB); PG8_STAGE(PG8_SA(0, 0), a2, voffA);
            PG8_WAIT_V(8); PG8_WAIT_L(0); PG8_BAR; PG8_MMA(1, 0, At, B0); PG8_MMA(1, 1, At, B1); PG8_BAR; PG8_SCHED;
            PG8_LDB(B0, 1, 0); PG8_LDB(B1, 1, 1); PG8_SCHED; PG8_LDA(At, 1, 0); PG8_STAGE(PG8_SA(0, 1), a2 + hstepA, voffA);
            PG8_WAIT_V(8); PG8_WAIT_L(0); PG8_BAR; PG8_MMA(0, 0, At, B0); PG8_MMA(0, 1, At, B1); PG8_BAR; PG8_SCHED;
            PG8_LDA(At, 1, 1); PG8_STAGE(PG8_SB(1, 0), b3, voffB); PG8_STAGE(PG8_SB(1, 1), b3 + hstepB, voffB); PG8_STAGE(PG8_SA(1, 0), a3, voffA);
            PG8_WAIT_V(8); PG8_WAIT_L(0); PG8_BAR; PG8_MMA(1, 0, At, B0); PG8_MMA(1, 1, At, B1); PG8_BAR; PG8_SCHED;
        }
        if (wr == 0) PG8_BAR;
        E(acc, cur, wr, wc, fr, fq);
        if (!has_next) break;
#pragma unroll
        for (int a = 0; a < 2; ++a)
#pragma unroll
            for (int b = 0; b < 2; ++b)
#pragma unroll
                for (int m = 0; m < 4; ++m)
#pragma unroll
                    for (int n = 0; n < 2; ++n) acc[a][b][m][n] = (f32x4){0.f, 0.f, 0.f, 0.f};
        cur = nxt; cA = nA; cB = nB; ++ui;
        if (wr == 1) PG8_BAR;
    }
    PG8_WAIT_V(0);
    PG8_BAR;
#undef PG8_SA
#undef PG8_SB
#undef PG8_STAGE
#undef PG8_LDA
#undef PG8_LDB
#undef PG8_MMA
#undef PG8_WAIT_V
#undef PG8_WAIT_L
#undef PG8_BAR
#undef PG8_SCHED
}
}

typedef f32x4 AccT[2][2][4][2];

struct EpiIn {
    bf16_t *Q, *Kb, *V, *U, *G; const float *qnw, *knw, *bgate, *rope;
    __device__ __forceinline__ void operator()(AccT& acc, const pg8::Unit& u, int wr, int wc, int fr, int fq) const {
        const int pn = u.pn, tok0 = u.pm * 256 + wr * 64 + fr;
        if (pn < 18) {
            const int sec = pn / 6, pt = pn - sec * 6, g = pt >> 1, head = 4 * (pt & 1) + wc;
            const int dsh = 2 * g, Lg = SEQ >> dsh;
            bf16_t* dst = Q + (size_t)sec * ((WS_K - WS_Q) / 2);
            const float* nw = qnw; if (sec == 1) nw = knw;
            if (sec < 2) {
                const int d00 = fq < 2 ? 4 * fq : 8 * fq, d01 = fq < 2 ? 4 * fq + 8 : 8 * fq + 4;
                const f32x4 w00 = *(const f32x4*)(nw + d00), w01 = *(const f32x4*)(nw + d01), w10 = *(const f32x4*)(nw + 32 + 8 * fq), w11 = *(const f32x4*)(nw + 36 + 8 * fq);
                const float sc = sec == 0 ? QSCALE : 1.0f;
#pragma unroll
                for (int ai = 0; ai < 2; ++ai)
#pragma unroll
                    for (int m = 0; m < 4; ++m) {
                        const int tok = tok0 + ai * 128 + m * 16, b = tok >> 11, s = tok & (SEQ - 1);
                        f32x4 v00 = acc[ai][0][m][0], v01 = acc[ai][0][m][1], v10 = acc[ai][1][m][0], v11 = acc[ai][1][m][1];
                        float ss = 0.f;
#pragma unroll
                        for (int e = 0; e < 4; ++e) ss += v00[e] * v00[e] + v01[e] * v01[e] + v10[e] * v10[e] + v11[e] * v11[e];
                        ss += __shfl_xor(ss, 16); ss += __shfl_xor(ss, 32);
                        const float rstd = __builtin_amdgcn_rsqf(ss * (1.0f / 64.0f) + EPS);
                        v00 = v00 * rstd * w00; v01 = v01 * rstd * w01; v10 = v10 * rstd * w10; v11 = v11 * rstd * w11;
                        const int fo = fq < 2 ? 4 * fq : 0;
                        const f32x4 cs = *(const f32x4*)(rope + (size_t)tok * 16 + fo), sn = *(const f32x4*)(rope + (size_t)tok * 16 + 8 + fo);
                        const f32x4 t1 = v00 * cs - v01 * sn, t2 = v01 * cs + v00 * sn;
                        if (fq < 2) { v00 = t1; v01 = t2; }
                        v00 = v00 * sc; v01 = v01 * sc; v10 = v10 * sc; v11 = v11 * sc;
                        const size_t row = (size_t)((b * NGRP + g) * NHEAD + head) * SEQ + (size_t)(s & ((1 << dsh) - 1)) * Lg + (s >> dsh);
                        bf16_t* p = dst + row * HD + 8 * fq;
                        u32x4 o0, o1;
                        o0.x = cvtpk(v00[0], v00[1]); o0.y = cvtpk(v00[2], v00[3]); o0.z = cvtpk(v01[0], v01[1]); o0.w = cvtpk(v01[2], v01[3]);
                        o1.x = cvtpk(v10[0], v10[1]); o1.y = cvtpk(v10[2], v10[3]); o1.z = cvtpk(v11[0], v11[1]); o1.w = cvtpk(v11[2], v11[3]);
                        *(u32x4*)p = o0; *(u32x4*)(p + 32) = o1;
                    }
            } else {
#pragma unroll
                for (int ai = 0; ai < 2; ++ai)
#pragma unroll
                    for (int m = 0; m < 4; ++m) {
                        const int tok = tok0 + ai * 128 + m * 16, b = tok >> 11, s = tok & (SEQ - 1);
                        const f32x4 v00 = acc[ai][0][m][0], v01 = acc[ai][0][m][1], v10 = acc[ai][1][m][0], v11 = acc[ai][1][m][1];
                        const size_t row = (size_t)((b * NGRP + g) * NHEAD + head) * SEQ + (size_t)(s & ((1 << dsh) - 1)) * Lg + (s >> dsh);
                        bf16_t* p = dst + row * HD + 8 * fq;
                        u32x4 o0, o1;
                        o0.x = cvtpk(v00[0], v00[1]); o0.y = cvtpk(v00[2], v00[3]); o0.z = cvtpk(v01[0], v01[1]); o0.w = cvtpk(v01[2], v01[3]);
                        o1.x = cvtpk(v10[0], v10[1]); o1.y = cvtpk(v10[2], v10[3]); o1.z = cvtpk(v11[0], v11[1]); o1.w = cvtpk(v11[2], v11[3]);
                        *(u32x4*)p = o0; *(u32x4*)(p + 32) = o1;
                    }
            }
        } else if (pn < 22) {
            const int ch0 = (pn - 18) * 128 + wc * 32 + 8 * fq;
#pragma unroll
            for (int ai = 0; ai < 2; ++ai)
#pragma unroll
                for (int m = 0; m < 4; ++m) {
                    const int tok = tok0 + ai * 128 + m * 16;
                    const f32x4 a0 = acc[ai][0][m][0], a1 = acc[ai][0][m][1], b0 = acc[ai][1][m][0], b1 = acc[ai][1][m][1];
                    f32x4 r0, r1;
#pragma unroll
                    for (int e = 0; e < 4; ++e) { r0[e] = a0[e] * sigmoidf_(b0[e]); r1[e] = a1[e] * sigmoidf_(b1[e]); }
                    u32x4 o; o.x = cvtpk(r0[0], r0[1]); o.y = cvtpk(r0[2], r0[3]); o.z = cvtpk(r1[0], r1[1]); o.w = cvtpk(r1[2], r1[3]);
                    *(u32x4*)(U + (size_t)tok * CCH + ch0) = o;
                }
        } else {
            const int c0 = (pn - 22) * 256 + wc * 32 + 8 * fq;
#pragma unroll
            for (int bj = 0; bj < 2; ++bj) {
                const f32x4 g0 = *(const f32x4*)(bgate + c0 + bj * 128), g1 = *(const f32x4*)(bgate + c0 + bj * 128 + 4);
#pragma unroll
                for (int ai = 0; ai < 2; ++ai)
#pragma unroll
                    for (int m = 0; m < 4; ++m) {
                        const int tok = tok0 + ai * 128 + m * 16;
                        const f32x4 a0 = acc[ai][bj][m][0] + g0, a1 = acc[ai][bj][m][1] + g1;
                        f32x4 r0, r1;
#pragma unroll
                        for (int e = 0; e < 4; ++e) { r0[e] = sigmoidf_(a0[e]); r1[e] = sigmoidf_(a1[e]); }
                        u32x4 o; o.x = cvtpk(r0[0], r0[1]); o.y = cvtpk(r0[2], r0[3]); o.z = cvtpk(r1[0], r1[1]); o.w = cvtpk(r1[2], r1[3]);
                        *(u32x4*)(G + (size_t)tok * 2048 + c0 + bj * 128) = o;
                    }
            }
        }
    }
};

struct EpiMix {
    const bf16_t* G; float* T; bf16_t* Z;
    __device__ __forceinline__ void operator()(AccT& acc, const pg8::Unit& u, int wr, int wc, int fr, int fq) const {
        const int tok0 = u.pm * 256 + wr * 64 + fr, c0 = u.pn * 256 + wc * 32 + 8 * fq;
#pragma unroll
        for (int ai = 0; ai < 2; ++ai)
#pragma unroll
            for (int m = 0; m < 4; ++m) {
                const int tok = tok0 + ai * 128 + m * 16;
#pragma unroll
                for (int bj = 0; bj < 2; ++bj) {
                    const int c = c0 + bj * 128;
                    const u32x4 gw = *(const u32x4*)(G + (size_t)tok * 2048 + u.kind * 1024 + c);
                    f32x4 g0 = {bf_lo(gw.x), bf_hi(gw.x), bf_lo(gw.y), bf_hi(gw.y)}, g1 = {bf_lo(gw.z), bf_hi(gw.z), bf_lo(gw.w), bf_hi(gw.w)};
                    f32x4 r0 = acc[ai][bj][m][0] * g0, r1 = acc[ai][bj][m][1] * g1;
                    float* tp = T + (size_t)tok * DM + c;
                    if (u.kind == 0) { *(f32x4*)tp = r0; *(f32x4*)(tp + 4) = r1; }
                    else {
                        r0 = r0 + *(const f32x4*)tp; r1 = r1 + *(const f32x4*)(tp + 4);
                        u32x4 o; o.x = cvtpk(r0[0], r0[1]); o.y = cvtpk(r0[2], r0[3]); o.z = cvtpk(r1[0], r1[1]); o.w = cvtpk(r1[2], r1[3]);
                        *(u32x4*)(Z + (size_t)tok * DM + c) = o;
                    }
                }
            }
    }
};

struct EpiOut {
    const float* X; float* X1; bf16_t* X1B; float* SSQ;
    __device__ __forceinline__ void operator()(AccT& acc, const pg8::Unit& u, int wr, int wc, int fr, int fq) const {
        const int tok0 = u.pm * 256 + wr * 64 + fr, c0 = u.pn * 256 + wc * 32 + 8 * fq;
#pragma unroll
        for (int ai = 0; ai < 2; ++ai)
#pragma unroll
            for (int m = 0; m < 4; ++m) {
                const int tok = tok0 + ai * 128 + m * 16; float ss = 0.f;
#pragma unroll
                for (int bj = 0; bj < 2; ++bj) {
                    const size_t off = (size_t)tok * DM + c0 + bj * 128;
                    const f32x4 r0 = acc[ai][bj][m][0] + *(const f32x4*)(X + off), r1 = acc[ai][bj][m][1] + *(const f32x4*)(X + off + 4);
                    *(f32x4*)(X1 + off) = r0; *(f32x4*)(X1 + off + 4) = r1;
                    u32x4 o; o.x = cvtpk(r0[0], r0[1]); o.y = cvtpk(r0[2], r0[3]); o.z = cvtpk(r1[0], r1[1]); o.w = cvtpk(r1[2], r1[3]);
                    *(u32x4*)(X1B + off) = o;
#pragma unroll
                    for (int e = 0; e < 4; ++e) ss += r0[e] * r0[e] + r1[e] * r1[e];
                }
                ss += __shfl_xor(ss, 16); ss += __shfl_xor(ss, 32);
                if (fq == 0) SSQ[(size_t)(u.pn * 4 + wc) * MTOK + tok] = ss;
            }
    }
};

struct EpiFfn1 {
    const float* SSQ; bf16_t* ACT;
    __device__ __forceinline__ void operator()(AccT& acc, const pg8::Unit& u, int wr, int wc, int fr, int fq) const {
        const int tok0 = u.pm * 256 + wr * 64 + fr, c0 = u.pn * 128 + wc * 32 + 8 * fq;
#pragma unroll
        for (int ai = 0; ai < 2; ++ai)
#pragma unroll
            for (int m = 0; m < 4; ++m) {
                const int tok = tok0 + ai * 128 + m * 16;
                float ss = 0.f;
#pragma unroll
                for (int j = 0; j < 4; ++j) ss += SSQ[(size_t)(4 * fq + j) * MTOK + tok];
                ss += __shfl_xor(ss, 16); ss += __shfl_xor(ss, 32);
                const float rstd = __builtin_amdgcn_rsqf(ss * (1.0f / DM) + EPS);
                const f32x4 a0 = acc[ai][0][m][0] * rstd, a1 = acc[ai][0][m][1] * rstd, b0 = acc[ai][1][m][0] * rstd, b1 = acc[ai][1][m][1] * rstd;
                f32x4 r0, r1;
#pragma unroll
                for (int e = 0; e < 4; ++e) { r0[e] = a0[e] * sigmoidf_(a0[e]) * b0[e]; r1[e] = a1[e] * sigmoidf_(a1[e]) * b1[e]; }
                u32x4 o; o.x = cvtpk(r0[0], r0[1]); o.y = cvtpk(r0[2], r0[3]); o.z = cvtpk(r1[0], r1[1]); o.w = cvtpk(r1[2], r1[3]);
                *(u32x4*)(ACT + (size_t)tok * DFF + c0) = o;
            }
    }
};

struct EpiFfn2 {
    float* OUT;
    __device__ __forceinline__ void operator()(AccT& acc, const pg8::Unit& u, int wr, int wc, int fr, int fq) const {
        const int tok0 = u.pm * 256 + wr * 64 + fr, c0 = u.pn * 256 + wc * 32 + 8 * fq;
#pragma unroll
        for (int ai = 0; ai < 2; ++ai)
#pragma unroll
            for (int m = 0; m < 4; ++m) {
                const int tok = tok0 + ai * 128 + m * 16;
#pragma unroll
                for (int bj = 0; bj < 2; ++bj) {
                    float* p = OUT + (size_t)tok * DM + c0 + bj * 128;
                    const f32x4 r0 = acc[ai][bj][m][0] + *(const f32x4*)p, r1 = acc[ai][bj][m][1] + *(const f32x4*)(p + 4);
                    *(f32x4*)p = r0; *(f32x4*)(p + 4) = r1;
                }
            }
    }
};

__device__ __forceinline__ void attn_tile(const bf16_t* Q, const bf16_t* K, const bf16_t* V, size_t seq0, int Lg, int q0, float negc,
                                          LAS unsigned char* vst, int lane, f32x16 (&o)[2], float& lsum) {
    const int r32 = lane & 31, hi = lane >> 5;
    bf16x8 qf[4];
    { const bf16_t* qp = Q + (seq0 + q0 + r32) * HD + 8 * hi;
#pragma unroll
      for (int s = 0; s < 4; ++s) qf[s] = *(const bf16x8*)(qp + 16 * s); }
#pragma unroll
    for (int r = 0; r < 16; ++r) { o[0][r] = 0.f; o[1][r] = 0.f; }
    lsum = 0.f;
    f32x16 cinit;
#pragma unroll
    for (int r = 0; r < 16; ++r) cinit[r] = negc;
    const int trb = (4 * hi + ((lane & 15) >> 2)) * 128 + ((lane >> 4) & 1) * 32 + (lane & 3) * 8;
#pragma unroll 1
    for (int kt = 0; kt < 5; ++kt) {
        const int k0 = q0 - 64 + 32 * kt;
        if (k0 < 0 || k0 >= Lg) continue;
        bf16x8 kf[4];
        { const bf16_t* kp = K + (seq0 + k0 + r32) * HD + 8 * hi;
#pragma unroll
          for (int s = 0; s < 4; ++s) kf[s] = *(const bf16x8*)(kp + 16 * s); }
        u32x4 vr[4];
#pragma unroll
        for (int i = 0; i < 4; ++i) { const int pc = lane + 64 * i; vr[i] = *(const u32x4*)(V + (seq0 + k0 + (pc >> 3)) * HD + (pc & 7) * 8); }
        f32x16 p = __builtin_amdgcn_mfma_f32_32x32x16_bf16(kf[0], qf[0], cinit, 0, 0, 0);
#pragma unroll
        for (int s = 1; s < 4; ++s) p = __builtin_amdgcn_mfma_f32_32x32x16_bf16(kf[s], qf[s], p, 0, 0, 0);
#pragma unroll
        for (int r = 0; r < 16; ++r) {
            const int kk = (r & 3) + 8 * (r >> 2) + 4 * hi;
            float e = __builtin_amdgcn_exp2f(p[r]);
            if (kt == 0) e = (kk >= r32) ? e : 0.f;
            if (kt == 4) e = (kk <= r32) ? e : 0.f;
            p[r] = e; lsum += e;
        }
        bf16x8 pb[2];
#pragma unroll
        for (int s = 0; s < 2; ++s) { u32x4 w; w.x = cvtpk(p[8 * s], p[8 * s + 1]); w.y = cvtpk(p[8 * s + 2], p[8 * s + 3]); w.z = cvtpk(p[8 * s + 4], p[8 * s + 5]); w.w = cvtpk(p[8 * s + 6], p[8 * s + 7]); pb[s] = __builtin_bit_cast(bf16x8, w); }
#pragma unroll
        for (int i = 0; i < 4; ++i) *(LAS u32x4*)(vst + (lane + 64 * i) * 16) = vr[i];
        LDS_WAIT();
#pragma unroll
        for (int dt = 0; dt < 2; ++dt)
#pragma unroll
            for (int s = 0; s < 2; ++s) {
                const s16x4 lo = __builtin_bit_cast(s16x4, __builtin_amdgcn_ds_read_tr16_b64_v4i16((LAS s16x4*)(vst + trb + dt * 64 + s * 2048)));
                const s16x4 hh = __builtin_bit_cast(s16x4, __builtin_amdgcn_ds_read_tr16_b64_v4i16((LAS s16x4*)(vst + trb + dt * 64 + s * 2048 + 1024)));
                const bf16x8 vf = {lo[0], lo[1], lo[2], lo[3], hh[0], hh[1], hh[2], hh[3]};
                o[dt] = __builtin_amdgcn_mfma_f32_32x32x16_bf16(vf, pb[s], o[dt], 0, 0, 0);
            }
        LDS_WAIT();
    }
}

__device__ __forceinline__ void attn_merge(LAS float* accO, LAS float* accL, const f32x16 (&o)[2], float lsum, int tk, int lane, bool first) {
    const int hi = lane >> 5;
    float l = lsum + __shfl_xor(lsum, 32);
    if (tk >= 0) {
#pragma unroll
        for (int dt = 0; dt < 2; ++dt)
#pragma unroll
            for (int rg = 0; rg < 4; ++rg) {
                LAS f32x4* p = (LAS f32x4*)(accO + tk * 68 + 32 * dt + 8 * rg + 4 * hi);
                f32x4 v = {o[dt][4 * rg], o[dt][4 * rg + 1], o[dt][4 * rg + 2], o[dt][4 * rg + 3]};
                if (!first) v = v + *p;
                *p = v;
            }
        if (hi == 0) { if (!first) l += accL[tk]; accL[tk] = l; }
    }
}

__device__ __forceinline__ void attn_item(const bf16_t* Q, const bf16_t* K, const bf16_t* V, bf16_t* AU, float negc, LAS unsigned char* scr, int item) {
    int tid = threadIdx.x; asm volatile("" : "+v"(tid));
    const int lane = tid & 63, w = __builtin_amdgcn_readfirstlane(tid >> 6), r32 = lane & 31;
    const int c = item & 7, h = (item >> 3) & 7, b = item >> 6;
    LAS float* accO = (LAS float*)scr;
    LAS float* accL = (LAS float*)(scr + 256 * 68 * 4);
    LAS unsigned char* vst = scr + 256 * 68 * 4 + 1024 + w * 4096;
    f32x16 o[2]; float ls;
    { const size_t seq0 = (size_t)((b * NGRP + 0) * NHEAD + h) * SEQ;
      attn_tile(Q, K, V, seq0, 2048, 256 * c + 32 * w, negc, vst, lane, o, ls);
      attn_merge(accO, accL, o, ls, 32 * w + r32, lane, true); }
    __syncthreads();
    { const int r = w >> 1; const size_t seq0 = (size_t)((b * NGRP + 1) * NHEAD + h) * SEQ + (size_t)r * 512;
      attn_tile(Q, K, V, seq0, 512, 64 * c + 32 * (w & 1), negc, vst, lane, o, ls);
      attn_merge(accO, accL, o, ls, 4 * (32 * (w & 1) + r32) + r, lane, false); }
    __syncthreads();
#pragma unroll 1
    for (int j = 0; j < 2; ++j) {
        const int r = 2 * w + j; const size_t seq0 = (size_t)((b * NGRP + 2) * NHEAD + h) * SEQ + (size_t)r * 128;
        attn_tile(Q, K, V, seq0, 128, 32 * (c >> 1), negc, vst, lane, o, ls);
        const int mm = r32 - 16 * (c & 1);
        attn_merge(accO, accL, o, ls, (mm >= 0 && mm < 16) ? 16 * mm + r : -1, lane, false);
    }
    __syncthreads();
    { const int tk = tid >> 1, half = tid & 1;
      const float rl = 1.0f / accL[tk];
      const LAS f32x4* p = (const LAS f32x4*)(accO + tk * 68 + 32 * half);
      bf16_t* dst = AU + (size_t)(b * SEQ + 256 * c + tk) * DM + h * HD + 32 * half;
#pragma unroll
      for (int i = 0; i < 4; ++i) { const f32x4 a = p[2 * i] * rl, bb = p[2 * i + 1] * rl;
          u32x4 ov; ov.x = cvtpk(a[0], a[1]); ov.y = cvtpk(a[2], a[3]); ov.z = cvtpk(bb[0], bb[1]); ov.w = cvtpk(bb[2], bb[3]);
          *(u32x4*)(dst + 8 * i) = ov; } }
    __syncthreads();
}

__device__ __forceinline__ void conv_unit(const bf16_t* U, const float* cw, const float* cb, const float* lnw, const float* lnb, bf16_t* AU, LAS unsigned char* scr, int unit) {
    int tid = threadIdx.x; asm volatile("" : "+v"(tid));
    const int lane = tid & 63, w = tid >> 6;
    const int b = unit >> 5, s0 = (unit & 31) * 64;
    const int cp = tid & 255, tg = tid >> 8;
    LAS float* cbuf = (LAS float*)scr;
    f32x2 wj[CW];
#pragma unroll
    for (int j = 0; j < CW; ++j) wj[j] = *(const f32x2*)(cw + j * CCH + 2 * cp);
    const f32x2 bias = *(const f32x2*)(cb + 2 * cp);
#pragma unroll 1
    for (int st = 0; st < 4; ++st) {
        const int t0 = 32 * tg + 8 * st;
        unsigned win[38];
#pragma unroll
        for (int i = 0; i < 38; ++i) { const int s = s0 + t0 - 15 + i; win[i] = (s >= 0 && s < SEQ) ? *(const unsigned*)(U + (size_t)(b * SEQ + s) * CCH + 2 * cp) : 0u; }
#pragma unroll
        for (int k = 0; k < 8; ++k) {
            f32x2 a = bias;
#pragma unroll
            for (int j = 0; j < CW; ++j) { a.x += wj[j].x * bf_lo(win[k + j]); a.y += wj[j].y * bf_hi(win[k + j]); }
            *(LAS f32x2*)(cbuf + (t0 + k) * 516 + 2 * cp) = a;
        }
    }
    __syncthreads();
    const f32x4 g0 = *(const f32x4*)(lnw + 4 * lane), g1 = *(const f32x4*)(lnw + 256 + 4 * lane), e0 = *(const f32x4*)(lnb + 4 * lane), e1 = *(const f32x4*)(lnb + 256 + 4 * lane);
#pragma unroll 1
    for (int k = 0; k < 8; ++k) {
        const int t = 8 * w + k;
        f32x4 a = *(const LAS f32x4*)(cbuf + t * 516 + 4 * lane), c = *(const LAS f32x4*)(cbuf + t * 516 + 256 + 4 * lane);
        const float mean = wave_sum((a[0] + a[1]) + (a[2] + a[3]) + (c[0] + c[1]) + (c[2] + c[3])) * (1.0f / CCH);
        a = a - mean; c = c - mean;
        const float var = wave_sum((a[0] * a[0] + a[1] * a[1]) + (a[2] * a[2] + a[3] * a[3]) + (c[0] * c[0] + c[1] * c[1]) + (c[2] * c[2] + c[3] * c[3])) * (1.0f / CCH);
        const float rstd = __builtin_amdgcn_rsqf(var + EPS);
        a = a * rstd * g0 + e0; c = c * rstd * g1 + e1;
#pragma unroll
        for (int e = 0; e < 4; ++e) { a[e] = a[e] * sigmoidf_(a[e]); c[e] = c[e] * sigmoidf_(c[e]); }
        bf16_t* dst = AU + (size_t)(b * SEQ + s0 + t) * DM + CCH;
        u32x2 oa, oc; oa.x = cvtpk(a[0], a[1]); oa.y = cvtpk(a[2], a[3]); oc.x = cvtpk(c[0], c[1]); oc.y = cvtpk(c[2], c[3]);
        *(u32x2*)(dst + 4 * lane) = oa; *(u32x2*)(dst + 256 + 4 * lane) = oc;
    }
    __syncthreads();
}

__device__ __forceinline__ void p0_item(const float* W, int N, int k0, int cbase, bool qkperm, const float* kscale, bf16_t* WT, int ldo, int kdst, int rho0, LAS float* scr, int lane) {
#pragma unroll 8
    for (int i = 0; i < 32; ++i) { const int kk = 2 * i + (lane >> 5); float v = W[(size_t)(k0 + kk) * N + cbase + (lane & 31)]; if (kscale) v *= kscale[k0 + kk]; scr[kk * 33 + (lane & 31)] = v; }
    LDS_WAIT(); asm volatile("" ::: "memory");
    const int c = lane & 7;
#pragma unroll
    for (int j = 0; j < 4; ++j) {
        const int n = (lane >> 3) + 8 * j;
        int src = perm32(n); if (qkperm) src = pos2dim(src);
        const LAS float* s = scr + (8 * c) * 33 + src;
        u32x4 o; o.x = cvtpk(s[0 * 33], s[1 * 33]); o.y = cvtpk(s[2 * 33], s[3 * 33]); o.z = cvtpk(s[4 * 33], s[5 * 33]); o.w = cvtpk(s[6 * 33], s[7 * 33]);
        *(u32x4*)(WT + (size_t)(rho0 + n) * ldo + kdst + k0 + 8 * c) = o;
    }
    LDS_WAIT(); asm volatile("" ::: "memory");
}

struct Params {
    const float* x; const int* pos; const float *norm1_w, *w_in, *b_gate, *q_norm_w, *k_norm_w, *w_o_attn, *conv_w, *conv_b, *conv_ln_w, *conv_ln_b, *w_pw_conv, *w_out, *norm2_w, *w_ffn_in, *w_ffn_out;
    float* out; unsigned char* ws;
};

__constant__ double c_invfreq[8] = {1.0, 0.19392274474868576, 0.03760603093086393, 0.007292664737217109, 0.001414213562373095, 0.0002742481756762073, 5.318295896944988e-05, 1.031338537721246e-05};

__device__ __forceinline__ void p0_prologue(const Params& P, LAS unsigned char* scrb, int vcu, int G) {
    int tid = threadIdx.x; asm volatile("" : "+v"(tid));
    const int lane = tid & 63, wave = tid >> 6;
    LAS float* scr = (LAS float*)(scrb + wave * 16384);
    const int gw = vcu * 8 + wave, NGW = G * 8;
    unsigned char* ws = P.ws;
    bf16_t* WIN = (bf16_t*)(ws + WS_WIN); bf16_t* WCAT = (bf16_t*)(ws + WS_WCAT); bf16_t* WOUT = (bf16_t*)(ws + WS_WOUT); bf16_t* WF1 = (bf16_t*)(ws + WS_WF1); bf16_t* WF2 = (bf16_t*)(ws + WS_WF2);
    constexpr int I_IN = 16 * (NIN / 32), I_O = 8 * 32, I_PW = 8 * 32, I_OUT = 16 * 32, I_F1 = 16 * (NF1 / 32), I_F2 = (DFF / 64) * 32;
    constexpr int NITEMS = I_IN + I_O + I_PW + I_OUT + I_F1 + I_F2;
    for (int it = gw; it < NITEMS; it += NGW) {
        int r = it;
        if (r < I_IN) {
            const int kb = r / (NIN / 32), gi = r % (NIN / 32), rho0 = gi * 32;
            const int pn = rho0 >> 8, bj = (rho0 >> 7) & 1, wc = (rho0 >> 5) & 3;
            int cbase; bool qk = false;
            if (pn < 18) { const int sec = pn / 6, pt = pn - sec * 6, g = pt >> 1, head = 4 * (pt & 1) + wc; cbase = sec * QKVW + g * 512 + head * 64 + 32 * bj; qk = (sec < 2) && (bj == 0); }
            else if (pn < 22) cbase = 3 * QKVW + 512 * bj + (pn - 18) * 128 + 32 * wc;
            else cbase = 3 * QKVW + 1024 + (pn - 22) * 256 + 128 * bj + 32 * wc;
            p0_item(P.w_in, NIN, kb * 64, cbase, qk, nullptr, WIN, DM, 0, rho0, scr, lane); continue; }
        r -= I_IN;
        if (r < I_O) { const int kb = r / 32, gi = r % 32; p0_item(P.w_o_attn, DM, kb * 64, gi * 32, false, nullptr, WCAT, DM, 0, gi * 32, scr, lane); continue; }
        r -= I_O;
        if (r < I_PW) { const int kb = r / 32, gi = r % 32; p0_item(P.w_pw_conv, DM, kb * 64, gi * 32, false, nullptr, WCAT, DM, 512, gi * 32, scr, lane); continue; }
        r -= I_PW;
        if (r < I_OUT) { const int kb = r / 32, gi = r % 32; p0_item(P.w_out, DM, kb * 64, gi * 32, false, nullptr, WOUT, DM, 0, gi * 32, scr, lane); continue; }
        r -= I_OUT;
        if (r < I_F1) {
            const int kb = r / (NF1 / 32), gi = r % (NF1 / 32), rho0 = gi * 32;
            const int pn = rho0 >> 8, bj = (rho0 >> 7) & 1, wc = (rho0 >> 5) & 3;
            p0_item(P.w_ffn_in, NF1, kb * 64, DFF * bj + 128 * pn + 32 * wc, false, P.norm2_w, WF1, DM, 0, rho0, scr, lane); continue; }
        r -= I_F1;
        { const int kb = r / 32, gi = r % 32; p0_item(P.w_ffn_out, DM, kb * 64, gi * 32, false, nullptr, WF2, DFF, 0, gi * 32, scr, lane); }
    }
    bf16_t* Hn = (bf16_t*)((unsigned char*)P.out + DO_H);
    for (int m = gw; m < MTOK; m += NGW) {
        const f32x4* xr = (const f32x4*)(P.x + (size_t)m * DM) + lane;
        f32x4 v[4]; float s = 0.f;
#pragma unroll
        for (int j = 0; j < 4; ++j) { v[j] = xr[64 * j]; s += (v[j][0] * v[j][0] + v[j][1] * v[j][1]) + (v[j][2] * v[j][2] + v[j][3] * v[j][3]); }
        const float rstd = __builtin_amdgcn_rsqf(wave_sum(s) * (1.0f / DM) + EPS);
        u32x2* o8 = (u32x2*)(Hn + (size_t)m * DM) + lane;
#pragma unroll
        for (int j = 0; j < 4; ++j) { const f32x4 nw = *((const f32x4*)P.norm1_w + lane + 64 * j); const f32x4 y = v[j] * rstd * nw; u32x2 o; o.x = cvtpk(y[0], y[1]); o.y = cvtpk(y[2], y[3]); o8[64 * j] = o; }
    }
    float* rope = (float*)(ws + WS_ROPE);
    for (int i = vcu * 512 + tid; i < MTOK * 8; i += G * 512) {
        const int tok = i >> 3, f = i & 7;
        const double ang = (double)P.pos[tok] * c_invfreq[f];
        const double kq = __builtin_rint(ang * 0.15915494309189535);
        const double xr = __builtin_fma(-kq, 6.283185307179586, ang) - kq * 2.4492935982947064e-16;
        const double x2 = xr * xr;
        double sn = 1.0, cs = 1.0;
#pragma unroll
        for (int n = 12; n >= 1; --n) { sn = 1.0 - sn * x2 / (double)((2 * n) * (2 * n + 1)); cs = 1.0 - cs * x2 / (double)((2 * n - 1) * (2 * n)); }
        sn *= xr;
        rope[(size_t)tok * 16 + f] = (float)cs; rope[(size_t)tok * 16 + 8 + f] = (float)sn;
    }
}

__global__ void __launch_bounds__(512, 2) fwd_kernel(Params P) {
    extern __shared__ __attribute__((aligned(16))) unsigned char lds_raw[];
    cg::grid_group grid = cg::this_grid();
    LAS unsigned char* lds = (LAS unsigned char*)lds_raw;
    LAS unsigned char* scr = lds + LDS_SCR;
    const int G = gridDim.x, bx = blockIdx.x;
    const int vcu = (G % 8 == 0) ? (bx % 8) * (G / 8) + bx / 8 : bx;
    unsigned char* ws = P.ws; unsigned char* ob = (unsigned char*)P.out;
    bf16_t* Qb = (bf16_t*)(ws + WS_Q); bf16_t* Kb = (bf16_t*)(ws + WS_K); bf16_t* Vb = (bf16_t*)(ws + WS_V); bf16_t* Gt = (bf16_t*)(ws + WS_GATE);
    bf16_t* Ub = (bf16_t*)(ob + DO_U); bf16_t* AU = (bf16_t*)(ob + DO_AU); bf16_t* Hn = (bf16_t*)(ob + DO_H);
    float* SSQ = (float*)(ws + WS_SSQ);

    p0_prologue(P, scr, vcu, G);
    grid.sync();

    { pg8::Gemm g{Hn, (const bf16_t*)(ws + WS_WIN), DM, DM, DM, 0}; pg8::StaticOrder S; S.init(MTOK, NIN, G, bx);
      EpiIn E{Qb, Kb, Vb, Ub, Gt, P.q_norm_w, P.k_norm_w, P.b_gate, (const float*)(ws + WS_ROPE)};
      pg8::gemm_phase(scr, g, S, E); }
    grid.sync();

    { float qm = 0.f, km = 0.f;
      for (int i = 0; i < HD; ++i) { qm = fmaxf(qm, fabsf(P.q_norm_w[i])); km = fmaxf(km, fabsf(P.k_norm_w[i])); }
      const float negc = -fminf(8.0f * qm * km * LOG2E, 60.0f);
      for (int it = vcu; it < BATCH * NHEAD * 8; it += G) attn_item(Qb, Kb, Vb, AU, negc, scr, it);
      for (int un = vcu; un < BATCH * 32; un += G) conv_unit(Ub, P.conv_w, P.conv_b, P.conv_ln_w, P.conv_ln_b, AU, scr, un); }
    grid.sync();

    { pg8::Gemm g{AU, (const bf16_t*)(ws + WS_WCAT), DM, DM, 512, 512}; pg8::StaticOrder S; S.init(MTOK, DM, G, bx, 2);
      EpiMix E{Gt, (float*)(ws + WS_T), (bf16_t*)(ws + WS_Z)};
      pg8::gemm_phase(scr, g, S, E); }
    grid.sync();

    { pg8::Gemm g{(const bf16_t*)(ws + WS_Z), (const bf16_t*)(ws + WS_WOUT), DM, DM, DM, 0}; pg8::StaticOrder S; S.init(MTOK, DM, G, bx);
      EpiOut E{P.x, P.out, (bf16_t*)(ws + WS_X1B), SSQ};
      pg8::gemm_phase(scr, g, S, E); }
    grid.sync();

    { pg8::Gemm g{(const bf16_t*)(ws + WS_X1B), (const bf16_t*)(ws + WS_WF1), DM, DM, DM, 0}; pg8::StaticOrder S; S.init(MTOK, NF1, G, bx);
      EpiFfn1 E{SSQ, (bf16_t*)(ws + WS_ACT)};
      pg8::gemm_phase(scr, g, S, E); }
    grid.sync();

    { pg8::Gemm g{(const bf16_t*)(ws + WS_ACT), (const bf16_t*)(ws + WS_WF2), DFF, DFF, DFF, 0}; pg8::StaticOrder S; S.init(MTOK, DM, G, bx);
      EpiFfn2 E{P.out};
      pg8::gemm_phase(scr, g, S, E); }
}

extern "C" void kernel_launch(void* const* d_in, const int* in_sizes, int n_in, void* d_out, int out_size, void* d_ws, size_t ws_size, hipStream_t stream) {
    static int grid = 0;
    if (grid == 0) {
        if (n_in != 17 || out_size != MTOK * DM || ws_size < WS_END) { fprintf(stderr, "kernel_launch: unexpected shapes (n_in %d out %d ws %zu)\n", n_in, out_size, ws_size); grid = -1; return; }
        int dev = 0, cus = 0, per_cu = 0;
        hipGetDevice(&dev);
        hipDeviceGetAttribute(&cus, hipDeviceAttributeMultiprocessorCount, dev);
        hipFuncSetAttribute((const void*)fwd_kernel, hipFuncAttributeMaxDynamicSharedMemorySize, LDS_BYTES);
        hipOccupancyMaxActiveBlocksPerMultiprocessor(&per_cu, (const void*)fwd_kernel, 512, LDS_BYTES);
        if (per_cu < 1) { fprintf(stderr, "kernel_launch: occupancy query says %d blocks per CU\n", per_cu); grid = -1; return; }
        grid = cus;
        fprintf(stderr, "kernel_launch: grid %d (occupancy %d per CU)\n", grid, per_cu);
    }
    if (grid < 0) return;
    Params p{};
    p.x = (const float*)d_in[0]; p.pos = (const int*)d_in[1]; p.norm1_w = (const float*)d_in[2]; p.w_in = (const float*)d_in[3]; p.b_gate = (const float*)d_in[4];
    p.q_norm_w = (const float*)d_in[5]; p.k_norm_w = (const float*)d_in[6]; p.w_o_attn = (const float*)d_in[7]; p.conv_w = (const float*)d_in[8]; p.conv_b = (const float*)d_in[9];
    p.conv_ln_w = (const float*)d_in[10]; p.conv_ln_b = (const float*)d_in[11]; p.w_pw_conv = (const float*)d_in[12]; p.w_out = (const float*)d_in[13]; p.norm2_w = (const float*)d_in[14];
    p.w_ffn_in = (const float*)d_in[15]; p.w_ffn_out = (const float*)d_in[16]; p.out = (float*)d_out; p.ws = (unsigned char*)d_ws;
    void* args[] = {&p};
    hipError_t e = hipLaunchCooperativeKernel((const void*)fwd_kernel, dim3(grid), dim3(512), args, LDS_BYTES, stream);
    if (e != hipSuccess) fprintf(stderr, "cooperative launch failed: %s (grid %d)\n", hipGetErrorString(e), grid);
}
```

```cpp
#include <hip/hip_runtime.h>
#include <hip/hip_cooperative_groups.h>
#include <cstdio>
#include <cstdint>
namespace cg = cooperative_groups;

#define LAS __attribute__((address_space(3)))
#define GAS __attribute__((address_space(1)))
typedef unsigned short bf16_t;
typedef short bf16x8 __attribute__((ext_vector_type(8)));
typedef short s16x4 __attribute__((ext_vector_type(4)));
typedef float f32x4 __attribute__((ext_vector_type(4)));
typedef float f32x2 __attribute__((ext_vector_type(2)));
typedef float f32x16 __attribute__((ext_vector_type(16)));
typedef unsigned u32x4 __attribute__((ext_vector_type(4)));
typedef unsigned u32x2 __attribute__((ext_vector_type(2)));
typedef __bf16 bf16x2_t __attribute__((ext_vector_type(2)));

constexpr int BATCH = 8, SEQ = 2048, DM = 1024, MTOK = BATCH * SEQ;
constexpr int NIN = 7680, DFF = 2816, NF1 = 2 * DFF;
constexpr int NGRP = 3, NHEAD = 8, HD = 64, QKVW = 1536, CCH = 512, CW = 31;
constexpr float EPS = 1e-6f;
constexpr float LOG2E = 1.4426950408889634f;
constexpr float QSCALE = 0.125f * LOG2E;

constexpr size_t MiB = 1u << 20;
constexpr size_t WS_CTL = 0, CTL_BYTES = 64 * 1024;
constexpr size_t WS_WIN = 1 * MiB;
constexpr size_t WS_WCAT = 16 * MiB;
constexpr size_t WS_WOUT = 18 * MiB;
constexpr size_t WS_WF1 = 20 * MiB;
constexpr size_t WS_WF2 = 31 * MiB;
constexpr size_t WS_SSQ = 37 * MiB;
constexpr size_t WS_ROPE = 38 * MiB;
constexpr size_t WS_Q = 40 * MiB;
constexpr size_t WS_K = 88 * MiB;
constexpr size_t WS_V = 136 * MiB;
constexpr size_t WS_GATE = 184 * MiB;
constexpr size_t WS_T = 40 * MiB;
constexpr size_t WS_Z = 104 * MiB;
constexpr size_t WS_X1B = 40 * MiB;
constexpr size_t WS_ACT = 72 * MiB;
constexpr size_t WS_END = 248 * MiB;
constexpr size_t DO_H = 0;
constexpr size_t DO_U = 32 * MiB;
constexpr size_t DO_AU = 0;

constexpr int LDS_MISC = 0, LDS_SCR = 1024, LDS_BYTES = 1024 + 139264;

__device__ __forceinline__ unsigned cvtpk(float lo, float hi) { f32x2 v = {lo, hi}; bf16x2_t b = __builtin_convertvector(v, bf16x2_t); return __builtin_bit_cast(unsigned, b); }
__device__ __forceinline__ float bf_lo(unsigned w) { return __uint_as_float(w << 16); }
__device__ __forceinline__ float bf_hi(unsigned w) { return __uint_as_float(w & 0xffff0000u); }
__device__ __forceinline__ float sigmoidf_(float x) { return __builtin_amdgcn_rcpf(1.0f + __builtin_amdgcn_exp2f(-x * LOG2E)); }
__device__ __forceinline__ float wave_sum(float v) {
#pragma unroll
    for (int o = 1; o < 64; o <<= 1) v += __shfl_xor(v, o);
    return v;
}
#define LDS_WAIT() asm volatile("s_waitcnt lgkmcnt(0)" ::: "memory")
#define VM_WAIT() asm volatile("s_waitcnt vmcnt(0)" ::: "memory")

__host__ __device__ __forceinline__ int pos2dim(int p) { return p < 16 ? (4 * (p >> 3) + 8 * ((p >> 2) & 1) + (p & 3)) : p; }
__host__ __device__ __forceinline__ int perm32(int rho) { const int n = rho >> 4, i = rho & 15; return 8 * (i >> 2) + 4 * n + (i & 3); }

namespace pg8 {
constexpr int BM = 256, BK = 64, HALF = 128, HTB = HALF * BK * 2, STAGE_BYTES = 8 * HTB, NXCD = 8, WGM = 4;
__host__ __device__ __forceinline__ int lds_byte(int r, int c) { const int st = (r >> 4) * 2 + (c >> 5), rr = r & 15, cc = c & 31, ob = rr * 64 + cc * 2; return st * 1024 + (ob ^ (((ob >> 9) & 1) << 5)); }
__host__ __device__ __forceinline__ void stage_rc(int b, int& R, int& C) { const int st = b / 1024, sb = b % 1024, swz = sb ^ (((sb >> 9) & 1) << 5); R = (st >> 1) * 16 + swz / 64; C = (st & 1) * 32 + (swz % 64) / 2; }

struct Unit { int pm, pn, kind; };
struct Gemm { const bf16_t* A; const bf16_t* Bt; int lda, ldb, K, koff; };

struct StaticOrder {
    int nM, nN, nwg, G, c, nkind;
    __device__ void init(int M, int N, int G_, int c_, int nkind_ = 1) { nM = M / BM; nN = N / BM; nwg = nM * nN; G = G_; c = c_; nkind = nkind_; }
    __device__ bool tile(long L, Unit& u) const {
        if (L >= nwg) return false;
        int wgid = (int)L; { const int q = nwg / NXCD, r = nwg % NXCD, xcd = wgid % NXCD, off = wgid / NXCD; wgid = (xcd < r ? xcd * (q + 1) : r * (q + 1) + (xcd - r) * q) + off; }
        const int nig = WGM * nN, gid = wgid / nig, fm = gid * WGM, gsz = (nM - fm) < WGM ? (nM - fm) : WGM;
        u.pm = fm + ((wgid % nig) % gsz); u.pn = (wgid % nig) / gsz; return true;
    }
    __device__ bool next(int i, Unit& u) const {
        if (nkind == 1) { u.kind = 0; return tile((long)i * G + c, u); }
        u.kind = i & 1; return tile((long)(i >> 1) * G + c, u);
    }
};

template <class Epi, class Sched>
__device__ __forceinline__ void gemm_phase(LAS unsigned char* lds, const Gemm g, const Sched& S, const Epi& E) {
    int tid = threadIdx.x; asm volatile("" : "+v"(tid));
    const int wid = __builtin_amdgcn_readfirstlane(tid >> 6), lane = tid & 63, wr = wid >> 2, wc = wid & 3, fr = lane & 15, fq = lane >> 4;
    const int nt = g.K / BK;
    unsigned voffA[2], voffB[2];
#pragma unroll
    for (int i = 0; i < 2; ++i) { int R, C; stage_rc(tid * 16 + i * 8192, R, C); voffA[i] = (unsigned)(R * g.lda + C) * 2u; voffB[i] = (unsigned)(R * g.ldb + C) * 2u; }
    const size_t kstep = (size_t)(BK * 2);
    const size_t hstepA = (size_t)HALF * g.lda * 2, hstepB = (size_t)HALF * g.ldb * 2;
    const size_t tstepA = 2 * hstepA, tstepB = 2 * hstepB;
    const unsigned ldsw = (unsigned)wid * 1024u;
    const int aoff = lds_byte(wr * 64 + fr, fq * 8), boff = lds_byte(wc * 32 + fr, fq * 8);
#define PG8_SA(b, h) (((b) * 2 + (h)) * HTB)
#define PG8_SB(b, h) ((4 + (b) * 2 + (h)) * HTB)
#define PG8_STAGE(bufoff, gbase, voff) do { _Pragma("unroll") for (int _i = 0; _i < 2; ++_i) \
        __builtin_amdgcn_global_load_lds((const unsigned*)((const char*)(gbase) + (voff)[_i]), (LAS unsigned*)(lds + (bufoff) + ldsw + _i * 8192), 16, 0, 0); } while (0)
#define PG8_LDA(dst, b, h) do { _Pragma("unroll") for (int m = 0; m < 4; ++m) _Pragma("unroll") for (int k = 0; k < 2; ++k) dst[m][k] = *(const LAS bf16x8*)(lds + PG8_SA(b, h) + aoff + m * 2048 + k * 1024); } while (0)
#define PG8_LDB(dst, b, h) do { _Pragma("unroll") for (int n = 0; n < 2; ++n) _Pragma("unroll") for (int k = 0; k < 2; ++k) dst[n][k] = *(const LAS bf16x8*)(lds + PG8_SB(b, h) + boff + n * 2048 + k * 1024); } while (0)
#define PG8_MMA(ai, bj, At, Bt) do { __builtin_amdgcn_s_setprio(1); _Pragma("unroll") for (int m = 0; m < 4; ++m) _Pragma("unroll") for (int n = 0; n < 2; ++n) _Pragma("unroll") for (int k = 0; k < 2; ++k) \
        acc[ai][bj][m][n] = __builtin_amdgcn_mfma_f32_16x16x32_bf16(Bt[n][k], At[m][k], acc[ai][bj][m][n], 0, 0, 0); __builtin_amdgcn_s_setprio(0); } while (0)
#define PG8_WAIT_V(n) asm volatile("s_waitcnt vmcnt(" #n ")" ::: "memory")
#define PG8_WAIT_L(n) asm volatile("s_waitcnt lgkmcnt(" #n ")" ::: "memory")
#define PG8_BAR __builtin_amdgcn_s_barrier()
#define PG8_SCHED __builtin_amdgcn_sched_barrier(0)
    Unit cur, nxt; int ui = 0;
    if (!S.next(0, cur)) return;
    f32x4 acc[2][2][4][2];
#pragma unroll
    for (int a = 0; a < 2; ++a)
#pragma unroll
        for (int b = 0; b < 2; ++b)
#pragma unroll
            for (int m = 0; m < 4; ++m)
#pragma unroll
                for (int n = 0; n < 2; ++n) acc[a][b][m][n] = (f32x4){0.f, 0.f, 0.f, 0.f};
    bf16x8 At[4][2], B0[2][2], B1[2][2];
    const char* cA = (const char*)g.A + (size_t)cur.pm * tstepA + (size_t)cur.kind * g.koff * 2;
    const char* cB = (const char*)g.Bt + (size_t)cur.pn * tstepB + (size_t)cur.kind * g.koff * 2;
    PG8_STAGE(PG8_SB(0, 0), cB, voffB); PG8_STAGE(PG8_SB(0, 1), cB + hstepB, voffB); PG8_STAGE(PG8_SA(0, 0), cA, voffA); PG8_STAGE(PG8_SA(0, 1), cA + hstepA, voffA);
    if (wr == 1) PG8_BAR;
    PG8_WAIT_V(2); PG8_BAR;
    PG8_STAGE(PG8_SB(1, 0), cB + kstep, voffB); PG8_STAGE(PG8_SA(1, 0), cA + kstep, voffA); PG8_STAGE(PG8_SB(1, 1), cB + hstepB + kstep, voffB);
    PG8_WAIT_V(6); PG8_BAR;
    for (;;) {
        const bool has_next = S.next(ui + 1, nxt);
        const char* nA = has_next ? (const char*)g.A + (size_t)nxt.pm * tstepA + (size_t)nxt.kind * g.koff * 2 : cA;
        const char* nB = has_next ? (const char*)g.Bt + (size_t)nxt.pn * tstepB + (size_t)nxt.kind * g.koff * 2 : cB;
        for (int t = 0; t < nt; t += 2) {
            const bool last = (t == nt - 2);
            const char* a1 = cA + (size_t)(t + 1) * kstep;
            const char* a2 = last ? nA : cA + (size_t)(t + 2) * kstep; const char* b2 = last ? nB : cB + (size_t)(t + 2) * kstep;
            const char* a3 = a2 + kstep; const char* b3 = b2 + kstep;
            PG8_LDB(B0, 0, 0); PG8_LDB(B1, 0, 1); PG8_SCHED; PG8_LDA(At, 0, 0); PG8_STAGE(PG8_SA(1, 1), a1 + hstepA, voffA);
            PG8_WAIT_V(8); PG8_WAIT_L(0); PG8_BAR; PG8_MMA(0, 0, At, B0); PG8_MMA(0, 1, At, B1); PG8_BAR; PG8_SCHED;
            PG8_LDA(At, 0, 1); PG8_STAGE(PG8_SB(0, 0), b2, voffB); PG8_STAGE(PG8_SB(0, 1), b2 + hstepB, voffB); PG8_STAGE(PG8_SA(0, 0), a2, voffA);
            PG8_WAIT_V(8); PG8_WAIT_L(0); PG8_BAR; PG8_MMA(1, 0, At, B0); PG8_MMA(1, 1, At, B1); PG8_BAR; PG8_SCHED;
            PG8_LDB(B0, 1, 0); PG8_LDB(B1, 1, 1); PG8_SCHED; PG8_LDA(At, 1, 0); PG8_STAGE(PG8_SA(0, 1), a2 + hstepA, voffA);
            PG8_WAIT_V(8); PG8_WAIT_L(0); PG8_BAR; PG8_MMA(0, 0, At, B0); PG8_MMA(0, 1, At, B1); PG8_BAR; PG8_SCHED;
            PG8_LDA(At, 1, 1); PG8_STAGE(PG8_SB(1, 0), b3, voffB); PG8_STAGE(PG8_SB(1, 1), b3 + hstepB, voffB); PG8_STAGE(PG8_SA(1, 0), a3, voffA);
            PG8_WAIT_V(8); PG8_WAIT_L(0); PG8_BAR; PG8_MMA(1, 0, At, B0); PG8_MMA(1, 1, At, B1); PG8_BAR; PG8_SCHED;
        }
        if (wr == 0) PG8_BAR;
        const bool keep = E(acc, cur, wr, wc, fr, fq);
        if (!has_next) break;
        if (!keep)
#pragma unroll
        for (int a = 0; a < 2; ++a)
#pragma unroll
            for (int b = 0; b < 2; ++b)
#pragma unroll
                for (int m = 0; m < 4; ++m)
#pragma unroll
                    for (int n = 0; n < 2; ++n) acc[a][b][m][n] = (f32x4){0.f, 0.f, 0.f, 0.f};
        cur = nxt; cA = nA; cB = nB; ++ui;
        if (wr == 1) PG8_BAR;
    }
    PG8_WAIT_V(0);
    PG8_BAR;
#undef PG8_SA
#undef PG8_SB
#undef PG8_STAGE
#undef PG8_LDA
#undef PG8_LDB
#undef PG8_MMA
#undef PG8_WAIT_V
#undef PG8_WAIT_L
#undef PG8_BAR
#undef PG8_SCHED
}
}

typedef f32x4 AccT[2][2][4][2];

struct EpiIn {
    bf16_t *Q, *Kb, *V, *U, *G; const float *qnw, *knw, *bgate, *rope;
    __device__ __forceinline__ bool operator()(AccT& acc, const pg8::Unit& u, int wr, int wc, int fr, int fq) const {
        const int pn = u.pn, tok0 = u.pm * 256 + wr * 64 + fr;
        if (pn < 18) {
            const int sec = pn / 6, pt = pn - sec * 6, g = pt >> 1, head = 4 * (pt & 1) + wc;
            const int dsh = 2 * g, Lg = SEQ >> dsh;
            bf16_t* dst = Q + (size_t)sec * ((WS_K - WS_Q) / 2);
            const float* nw = qnw; if (sec == 1) nw = knw;
            if (sec < 2) {
                const int d00 = fq < 2 ? 4 * fq : 8 * fq, d01 = fq < 2 ? 4 * fq + 8 : 8 * fq + 4;
                const f32x4 w00 = *(const f32x4*)(nw + d00), w01 = *(const f32x4*)(nw + d01), w10 = *(const f32x4*)(nw + 32 + 8 * fq), w11 = *(const f32x4*)(nw + 36 + 8 * fq);
                const float sc = sec == 0 ? QSCALE : 1.0f;
#pragma unroll
                for (int ai = 0; ai < 2; ++ai)
#pragma unroll
                    for (int m = 0; m < 4; ++m) {
                        const int tok = tok0 + ai * 128 + m * 16, b = tok >> 11, s = tok & (SEQ - 1);
                        f32x4 v00 = acc[ai][0][m][0], v01 = acc[ai][0][m][1], v10 = acc[ai][1][m][0], v11 = acc[ai][1][m][1];
                        float ss = 0.f;
#pragma unroll
                        for (int e = 0; e < 4; ++e) ss += v00[e] * v00[e] + v01[e] * v01[e] + v10[e] * v10[e] + v11[e] * v11[e];
                        ss += __shfl_xor(ss, 16); ss += __shfl_xor(ss, 32);
                        const float rstd = __builtin_amdgcn_rsqf(ss * (1.0f / 64.0f) + EPS);
                        v00 = v00 * rstd * w00; v01 = v01 * rstd * w01; v10 = v10 * rstd * w10; v11 = v11 * rstd * w11;
                        const int fo = fq < 2 ? 4 * fq : 0;
                        const f32x4 cs = *(const f32x4*)(rope + (size_t)tok * 16 + fo), sn = *(const f32x4*)(rope + (size_t)tok * 16 + 8 + fo);
                        const f32x4 t1 = v00 * cs - v01 * sn, t2 = v01 * cs + v00 * sn;
                        if (fq < 2) { v00 = t1; v01 = t2; }
                        v00 = v00 * sc; v01 = v01 * sc; v10 = v10 * sc; v11 = v11 * sc;
                        const size_t row = (size_t)((b * NGRP + g) * NHEAD + head) * SEQ + (size_t)(s & ((1 << dsh) - 1)) * Lg + (s >> dsh);
                        bf16_t* p = dst + row * HD + 8 * fq;
                        u32x4 o0, o1;
                        o0.x = cvtpk(v00[0], v00[1]); o0.y = cvtpk(v00[2], v00[3]); o0.z = cvtpk(v01[0], v01[1]); o0.w = cvtpk(v01[2], v01[3]);
                        o1.x = cvtpk(v10[0], v10[1]); o1.y = cvtpk(v10[2], v10[3]); o1.z = cvtpk(v11[0], v11[1]); o1.w = cvtpk(v11[2], v11[3]);
                        *(u32x4*)p = o0; *(u32x4*)(p + 32) = o1;
                    }
            } else {
#pragma unroll
                for (int ai = 0; ai < 2; ++ai)
#pragma unroll
                    for (int m = 0; m < 4; ++m) {
                        const int tok = tok0 + ai * 128 + m * 16, b = tok >> 11, s = tok & (SEQ - 1);
                        const f32x4 v00 = acc[ai][0][m][0], v01 = acc[ai][0][m][1], v10 = acc[ai][1][m][0], v11 = acc[ai][1][m][1];
                        const size_t row = (size_t)((b * NGRP + g) * NHEAD + head) * SEQ + (size_t)(s & ((1 << dsh) - 1)) * Lg + (s >> dsh);
                        bf16_t* p = dst + row * HD + 8 * fq;
                        u32x4 o0, o1;
                        o0.x = cvtpk(v00[0], v00[1]); o0.y = cvtpk(v00[2], v00[3]); o0.z = cvtpk(v01[0], v01[1]); o0.w = cvtpk(v01[2], v01[3]);
                        o1.x = cvtpk(v10[0], v10[1]); o1.y = cvtpk(v10[2], v10[3]); o1.z = cvtpk(v11[0], v11[1]); o1.w = cvtpk(v11[2], v11[3]);
                        *(u32x4*)p = o0; *(u32x4*)(p + 32) = o1;
                    }
            }
        } else if (pn < 22) {
            const int ch0 = (pn - 18) * 128 + wc * 32 + 8 * fq;
#pragma unroll
            for (int ai = 0; ai < 2; ++ai)
#pragma unroll
                for (int m = 0; m < 4; ++m) {
                    const int tok = tok0 + ai * 128 + m * 16;
                    const f32x4 a0 = acc[ai][0][m][0], a1 = acc[ai][0][m][1], b0 = acc[ai][1][m][0], b1 = acc[ai][1][m][1];
                    f32x4 r0, r1;
#pragma unroll
                    for (int e = 0; e < 4; ++e) { r0[e] = a0[e] * sigmoidf_(b0[e]); r1[e] = a1[e] * sigmoidf_(b1[e]); }
                    u32x4 o; o.x = cvtpk(r0[0], r0[1]); o.y = cvtpk(r0[2], r0[3]); o.z = cvtpk(r1[0], r1[1]); o.w = cvtpk(r1[2], r1[3]);
                    *(u32x4*)(U + (size_t)tok * CCH + ch0) = o;
                }
        } else {
            const int c0 = (pn - 22) * 256 + wc * 32 + 8 * fq;
#pragma unroll
            for (int bj = 0; bj < 2; ++bj) {
                const f32x4 g0 = *(const f32x4*)(bgate + c0 + bj * 128), g1 = *(const f32x4*)(bgate + c0 + bj * 128 + 4);
#pragma unroll
                for (int ai = 0; ai < 2; ++ai)
#pragma unroll
                    for (int m = 0; m < 4; ++m) {
                        const int tok = tok0 + ai * 128 + m * 16;
                        const f32x4 a0 = acc[ai][bj][m][0] + g0, a1 = acc[ai][bj][m][1] + g1;
                        f32x4 r0, r1;
#pragma unroll
                        for (int e = 0; e < 4; ++e) { r0[e] = sigmoidf_(a0[e]); r1[e] = sigmoidf_(a1[e]); }
                        u32x4 o; o.x = cvtpk(r0[0], r0[1]); o.y = cvtpk(r0[2], r0[3]); o.z = cvtpk(r1[0], r1[1]); o.w = cvtpk(r1[2], r1[3]);
                        *(u32x4*)(G + (size_t)tok * 2048 + c0 + bj * 128) = o;
                    }
            }
        }
        return false;
    }
};

struct EpiMix {
    const bf16_t* G; bf16_t* Z;
    __device__ __forceinline__ bool operator()(AccT& acc, const pg8::Unit& u, int wr, int wc, int fr, int fq) const {
        const int tok0 = u.pm * 256 + wr * 64 + fr, c0 = u.pn * 256 + wc * 32 + 8 * fq;
#pragma unroll
        for (int ai = 0; ai < 2; ++ai)
#pragma unroll
            for (int m = 0; m < 4; ++m) {
                const int tok = tok0 + ai * 128 + m * 16;
#pragma unroll
                for (int bj = 0; bj < 2; ++bj) {
                    const int c = c0 + bj * 128;
                    const u32x4 gb = *(const u32x4*)(G + (size_t)tok * 2048 + 1024 + c);
                    f32x4 b0 = {bf_lo(gb.x), bf_hi(gb.x), bf_lo(gb.y), bf_hi(gb.y)}, b1 = {bf_lo(gb.z), bf_hi(gb.z), bf_lo(gb.w), bf_hi(gb.w)};
#pragma unroll
                    for (int e = 0; e < 4; ++e) { b0[e] = fmaxf(b0[e], 1e-30f); b1[e] = fmaxf(b1[e], 1e-30f); }
                    if (u.kind == 0) {
                        const u32x4 ga = *(const u32x4*)(G + (size_t)tok * 2048 + c);
                        const f32x4 a0 = {bf_lo(ga.x), bf_hi(ga.x), bf_lo(ga.y), bf_hi(ga.y)}, a1 = {bf_lo(ga.z), bf_hi(ga.z), bf_lo(ga.w), bf_hi(ga.w)};
#pragma unroll
                        for (int e = 0; e < 4; ++e) { acc[ai][bj][m][0][e] *= a0[e] * __builtin_amdgcn_rcpf(b0[e]); acc[ai][bj][m][1][e] *= a1[e] * __builtin_amdgcn_rcpf(b1[e]); }
                    } else {
                        const f32x4 r0 = acc[ai][bj][m][0] * b0, r1 = acc[ai][bj][m][1] * b1;
                        u32x4 o; o.x = cvtpk(r0[0], r0[1]); o.y = cvtpk(r0[2], r0[3]); o.z = cvtpk(r1[0], r1[1]); o.w = cvtpk(r1[2], r1[3]);
                        *(u32x4*)(Z + (size_t)tok * DM + c) = o;
                    }
                }
            }
        return u.kind == 0;
    }
};

struct EpiOut {
    const float* X; bf16_t* X1B; float* SSQ;
    __device__ __forceinline__ bool operator()(AccT& acc, const pg8::Unit& u, int wr, int wc, int fr, int fq) const {
        const int tok0 = u.pm * 256 + wr * 64 + fr, c0 = u.pn * 256 + wc * 32 + 8 * fq;
#pragma unroll
        for (int ai = 0; ai < 2; ++ai)
#pragma unroll
            for (int m = 0; m < 4; ++m) {
                const int tok = tok0 + ai * 128 + m * 16; float ss = 0.f;
#pragma unroll
                for (int bj = 0; bj < 2; ++bj) {
                    const size_t off = (size_t)tok * DM + c0 + bj * 128;
                    const f32x4 r0 = acc[ai][bj][m][0] + *(const f32x4*)(X + off), r1 = acc[ai][bj][m][1] + *(const f32x4*)(X + off + 4);
                    u32x4 o; o.x = cvtpk(r0[0], r0[1]); o.y = cvtpk(r0[2], r0[3]); o.z = cvtpk(r1[0], r1[1]); o.w = cvtpk(r1[2], r1[3]);
                    *(u32x4*)(X1B + off) = o;
#pragma unroll
                    for (int e = 0; e < 4; ++e) ss += r0[e] * r0[e] + r1[e] * r1[e];
                }
                ss += __shfl_xor(ss, 16); ss += __shfl_xor(ss, 32);
                if (fq == 0) SSQ[(size_t)(u.pn * 4 + wc) * MTOK + tok] = ss;
            }
        return false;
    }
};

struct EpiFfn1 {
    const float* SSQ; bf16_t* ACT;
    __device__ __forceinline__ bool operator()(AccT& acc, const pg8::Unit& u, int wr, int wc, int fr, int fq) const {
        const int tok0 = u.pm * 256 + wr * 64 + fr, c0 = u.pn * 128 + wc * 32 + 8 * fq;
#pragma unroll
        for (int ai = 0; ai < 2; ++ai)
#pragma unroll
            for (int m = 0; m < 4; ++m) {
                const int tok = tok0 + ai * 128 + m * 16;
                float ss = 0.f;
#pragma unroll
                for (int j = 0; j < 4; ++j) ss += SSQ[(size_t)(4 * fq + j) * MTOK + tok];
                ss += __shfl_xor(ss, 16); ss += __shfl_xor(ss, 32);
                const float rstd = __builtin_amdgcn_rsqf(ss * (1.0f / DM) + EPS);
                const f32x4 a0 = acc[ai][0][m][0] * rstd, a1 = acc[ai][0][m][1] * rstd, b0 = acc[ai][1][m][0] * rstd, b1 = acc[ai][1][m][1] * rstd;
                f32x4 r0, r1;
#pragma unroll
                for (int e = 0; e < 4; ++e) { r0[e] = a0[e] * sigmoidf_(a0[e]) * b0[e]; r1[e] = a1[e] * sigmoidf_(a1[e]) * b1[e]; }
                u32x4 o; o.x = cvtpk(r0[0], r0[1]); o.y = cvtpk(r0[2], r0[3]); o.z = cvtpk(r1[0], r1[1]); o.w = cvtpk(r1[2], r1[3]);
                *(u32x4*)(ACT + (size_t)tok * DFF + c0) = o;
            }
        return false;
    }
};

struct EpiFfn2 {
    const bf16_t* X1B; float* OUT;
    __device__ __forceinline__ bool operator()(AccT& acc, const pg8::Unit& u, int wr, int wc, int fr, int fq) const {
        const int tok0 = u.pm * 256 + wr * 64 + fr, c0 = u.pn * 256 + wc * 32 + 8 * fq;
#pragma unroll
        for (int ai = 0; ai < 2; ++ai)
#pragma unroll
            for (int m = 0; m < 4; ++m) {
                const int tok = tok0 + ai * 128 + m * 16;
#pragma unroll
                for (int bj = 0; bj < 2; ++bj) {
                    const size_t off = (size_t)tok * DM + c0 + bj * 128;
                    const u32x4 xw = *(const u32x4*)(X1B + off);
                    const f32x4 x0 = {bf_lo(xw.x), bf_hi(xw.x), bf_lo(xw.y), bf_hi(xw.y)}, x1 = {bf_lo(xw.z), bf_hi(xw.z), bf_lo(xw.w), bf_hi(xw.w)};
                    *(f32x4*)(OUT + off) = acc[ai][bj][m][0] + x0; *(f32x4*)(OUT + off + 4) = acc[ai][bj][m][1] + x1;
                }
            }
        return false;
    }
};

struct AttnRing { u32x4 kr[4]; u32x4 vr[4]; };
__device__ __forceinline__ void att_load(AttnRing& R, const bf16_t* K, const bf16_t* V, int voff, int kt, int klo, int khi) {
    if (kt >= klo && kt <= khi) {
        const bf16_t* kp = K + (voff + kt * 32 * HD); const bf16_t* vp = V + (voff + kt * 32 * HD);
#pragma unroll
        for (int i = 0; i < 4; ++i) R.kr[i] = *(const u32x4*)(kp + i * 8 * HD);
#pragma unroll
        for (int i = 0; i < 4; ++i) R.vr[i] = *(const u32x4*)(vp + i * 8 * HD);
    }
}
template <int KT>
__device__ __forceinline__ void att_step(const AttnRing& R, const bf16x8 (&qf)[4], int klo, int khi, LAS unsigned char* vst, int vwr, int trb0, int trb1,
                                         LAS unsigned char* kst, int kw0, int kw1, int krd, int kf_, int r32, int hi, f32x16 (&o)[2], float& lsum) {
    if (KT >= klo && KT <= khi) {
#pragma unroll
        for (int i = 0; i < 4; ++i) *(LAS u32x4*)(kst + ((i & 1) ? kw1 : kw0) + i * 1024) = R.kr[i];
#pragma unroll
        for (int i = 0; i < 4; ++i) *(LAS u32x4*)(vst + vwr + i * 1024) = R.vr[i];
        bf16x8 kf[4];
#pragma unroll
        for (int s = 0; s < 4; ++s) kf[s] = *(const LAS bf16x8*)(kst + krd + (((2 * s + hi) ^ kf_) << 4));
        f32x16 p = {0.f, 0.f, 0.f, 0.f, 0.f, 0.f, 0.f, 0.f, 0.f, 0.f, 0.f, 0.f, 0.f, 0.f, 0.f, 0.f};
#pragma unroll
        for (int s = 0; s < 4; ++s) p = __builtin_amdgcn_mfma_f32_32x32x16_bf16(kf[s], qf[s], p, 0, 0, 0);
#pragma unroll
        for (int r = 0; r < 16; ++r) { const int kk = (r & 3) + 8 * (r >> 2) + 4 * hi; float e = __builtin_amdgcn_exp2f(p[r]);
            if (KT == 0) e = (kk >= r32) ? e : 0.f;
            if (KT == 4) e = (kk <= r32) ? e : 0.f;
            p[r] = e; }
        lsum += ((p[0] + p[1]) + (p[2] + p[3])) + ((p[4] + p[5]) + (p[6] + p[7])) + (((p[8] + p[9]) + (p[10] + p[11])) + ((p[12] + p[13]) + (p[14] + p[15])));
        bf16x8 pb[2];
#pragma unroll
        for (int s = 0; s < 2; ++s) { u32x4 w; w.x = cvtpk(p[8 * s], p[8 * s + 1]); w.y = cvtpk(p[8 * s + 2], p[8 * s + 3]); w.z = cvtpk(p[8 * s + 4], p[8 * s + 5]); w.w = cvtpk(p[8 * s + 6], p[8 * s + 7]); pb[s] = __builtin_bit_cast(bf16x8, w); }
#pragma unroll
        for (int dt = 0; dt < 2; ++dt)
#pragma unroll
            for (int s = 0; s < 2; ++s) {
                const int tb = dt ? trb1 : trb0;
                const s16x4 lo = __builtin_bit_cast(s16x4, __builtin_amdgcn_ds_read_tr16_b64_v4i16((LAS s16x4*)(vst + tb + s * 2048)));
                const s16x4 hh = __builtin_bit_cast(s16x4, __builtin_amdgcn_ds_read_tr16_b64_v4i16((LAS s16x4*)(vst + tb + s * 2048 + 1024)));
                const bf16x8 vf = {lo[0], lo[1], lo[2], lo[3], hh[0], hh[1], hh[2], hh[3]};
                o[dt] = __builtin_amdgcn_mfma_f32_32x32x16_bf16(vf, pb[s], o[dt], 0, 0, 0);
            }
        LDS_WAIT();
    }
}
__device__ __forceinline__ int acc_row(int t) { return (t & 0xF0) | ((t + (t >> 4)) & 15); }
__device__ __forceinline__ void attn_merge(LAS float* accO, LAS float* accL, const f32x16 (&o)[2], float l, int tk, int hi, bool first) {
    if (tk >= 0) {
        const int row = acc_row(tk);
#pragma unroll
        for (int dt = 0; dt < 2; ++dt)
#pragma unroll
            for (int rg = 0; rg < 4; ++rg) {
                LAS f32x4* p = (LAS f32x4*)(accO + row * 68 + 32 * dt + 8 * rg + 4 * hi);
                f32x4 v = {o[dt][4 * rg], o[dt][4 * rg + 1], o[dt][4 * rg + 2], o[dt][4 * rg + 3]};
                if (!first) v = v + *p;
                *p = v;
            }
        if (hi == 0) { if (!first) l += accL[tk]; accL[tk] = l; }
    }
}
__device__ __forceinline__ void attn_finalize(const LAS float* accO, const LAS float* accL, bf16_t* AU, int b, int h, int chunk, int tid) {
    const int tk = tid >> 1, half = tid & 1;
    const float rl = 1.0f / accL[tk];
    const LAS f32x4* p = (const LAS f32x4*)(accO + acc_row(tk) * 68 + 32 * half);
    bf16_t* dst = AU + (size_t)(b * SEQ + 256 * chunk + tk) * DM + h * HD + 32 * half;
#pragma unroll
    for (int i = 0; i < 4; ++i) { const f32x4 a = p[2 * i] * rl, bb = p[2 * i + 1] * rl;
        u32x4 ov; ov.x = cvtpk(a[0], a[1]); ov.y = cvtpk(a[2], a[3]); ov.z = cvtpk(bb[0], bb[1]); ov.w = cvtpk(bb[2], bb[3]);
        *(u32x4*)(dst + 8 * i) = ov; }
}
struct AttnTile { size_t seq0; int Lg, q0; };
__device__ __forceinline__ AttnTile attn_desc(int j, int b, int h, int sc, int w) {
    AttnTile t;
    if (j < 2) { t.seq0 = (size_t)((b * NGRP + 2) * NHEAD + h) * SEQ + (size_t)(2 * w + j) * 128; t.Lg = 128; t.q0 = 32 * sc; }
    else { const int c = 2 * sc + ((j - 2) >> 1);
        if ((j & 1) == 0) { t.seq0 = (size_t)((b * NGRP + 0) * NHEAD + h) * SEQ; t.Lg = 2048; t.q0 = 256 * c + 32 * w; }
        else { t.seq0 = (size_t)((b * NGRP + 1) * NHEAD + h) * SEQ + (size_t)(w >> 1) * 512; t.Lg = 512; t.q0 = 64 * c + 32 * (w & 1); } }
    return t;
}
__device__ __forceinline__ void attn_super(const bf16_t* Q, const bf16_t* K, const bf16_t* V, bf16_t* AU, float negc, LAS unsigned char* scr, int item) {
    int tid = threadIdx.x; asm volatile("" : "+v"(tid));
    const int lane = tid & 63, w = __builtin_amdgcn_readfirstlane(tid >> 6), r32 = lane & 31, hi = lane >> 5;
    const int sc = item & 3, h = (item >> 2) & 7, b = item >> 5;
    LAS float* accO = (LAS float*)scr;
    LAS float* accL = (LAS float*)(scr + 256 * 68 * 4);
    LAS unsigned char* vst = scr + 256 * 68 * 4 + 1024 + w * 4096;
    const int vwr = (lane >> 3) * 128 + (((lane & 7) * 16) ^ (((lane >> 4) & 1) << 6));
    const int qsw = ((lane & 15) >> 3) & 1;
    const int trrow = (4 * hi + ((lane & 15) >> 2)) * 128 + ((lane >> 4) & 1) * 32 + (lane & 3) * 8;
    const int trb0 = trrow + 64 * qsw, trb1 = trrow + 64 * (1 - qsw);
    LAS unsigned char* kst = scr + 256 * 68 * 4 + 1024 + 32768 + w * 4096;
    const int kw0 = (lane >> 3) * 128 + (((lane & 7) ^ (lane >> 4)) << 4), kw1 = (lane >> 3) * 128 + (((lane & 7) ^ ((lane >> 4) + 4)) << 4);
    const int krd = r32 * 128, kf_ = (r32 >> 1) & 7;
    AttnRing R0, R1, R2;
    f32x16 og2[2]; float lg2 = 0.f;
    AttnTile cur = attn_desc(0, b, h, sc, w);
    int klo = cur.q0 >= 64 ? 0 : 2 - (cur.q0 >> 5), khi = ((cur.Lg - cur.q0 + 32) >> 5) > 4 ? 4 : ((cur.Lg - cur.q0 + 32) >> 5);
    int voff = ((int)cur.seq0 + cur.q0 - 64 + (lane >> 3)) * HD + (lane & 7) * 8;
    bf16x8 qf[4];
    att_load(R0, K, V, voff, 0, klo, khi); att_load(R1, K, V, voff, 1, klo, khi);
    { const bf16_t* qp = Q + (cur.seq0 + cur.q0 + r32) * HD + 8 * hi;
#pragma unroll
      for (int s = 0; s < 4; ++s) qf[s] = *(const bf16x8*)(qp + 16 * s); }
#pragma unroll 1
    for (int j = 0; j < 6; ++j) {
        f32x16 o[2]; float ls = 0.f;
#pragma unroll
        for (int r = 0; r < 16; ++r) { o[0][r] = 0.f; o[1][r] = 0.f; }
        att_load(R2, K, V, voff, 2, klo, khi);
        att_step<0>(R0, qf, klo, khi, vst, vwr, trb0, trb1, kst, kw0, kw1, krd, kf_, r32, hi, o, ls);
        att_load(R0, K, V, voff, 3, klo, khi);
        att_step<1>(R1, qf, klo, khi, vst, vwr, trb0, trb1, kst, kw0, kw1, krd, kf_, r32, hi, o, ls);
        att_load(R1, K, V, voff, 4, klo, khi);
        att_step<2>(R2, qf, klo, khi, vst, vwr, trb0, trb1, kst, kw0, kw1, krd, kf_, r32, hi, o, ls);
        const AttnTile nxt = attn_desc(j < 5 ? j + 1 : 5, b, h, sc, w);
        const int nklo = nxt.q0 >= 64 ? 0 : 2 - (nxt.q0 >> 5), nkhi = ((nxt.Lg - nxt.q0 + 32) >> 5) > 4 ? 4 : ((nxt.Lg - nxt.q0 + 32) >> 5);
        const int nvoff = ((int)nxt.seq0 + nxt.q0 - 64 + (lane >> 3)) * HD + (lane & 7) * 8;
        att_step<3>(R0, qf, klo, khi, vst, vwr, trb0, trb1, kst, kw0, kw1, krd, kf_, r32, hi, o, ls);
        if (j < 5) att_load(R0, K, V, nvoff, 0, nklo, nkhi);
        att_step<4>(R1, qf, klo, khi, vst, vwr, trb0, trb1, kst, kw0, kw1, krd, kf_, r32, hi, o, ls);
        if (j < 5) { att_load(R1, K, V, nvoff, 1, nklo, nkhi);
            const bf16_t* qp = Q + (nxt.seq0 + nxt.q0 + r32) * HD + 8 * hi;
#pragma unroll
            for (int s = 0; s < 4; ++s) qf[s] = *(const bf16x8*)(qp + 16 * s); }
        const float l = ls + __shfl_xor(ls, 32);
        int tq = threadIdx.x; asm volatile("" : "+v"(tq));
        const int r32m = tq & 31, him = (tq >> 5) & 1;
        if (j < 2) {
            attn_merge(accO, accL, o, l, r32m < 16 ? 16 * r32m + 2 * w + j : -1, him, true);
            if (j == 0) { og2[0] = o[0]; og2[1] = o[1]; lg2 = l; }
            else {
#pragma unroll
                for (int r = 0; r < 16; ++r) { const float m0 = __shfl_xor(o[0][r], 16), m1 = __shfl_xor(o[1][r], 16); if (r32m < 16) { og2[0][r] = m0; og2[1][r] = m1; } }
                const float ml = __shfl_xor(l, 16); if (r32m < 16) lg2 = ml;
            }
        } else if ((j & 1) == 0) {
            __syncthreads();
            attn_merge(accO, accL, o, l, 32 * w + r32m, him, false);
        } else {
            __syncthreads();
            attn_merge(accO, accL, o, l, 4 * (32 * (w & 1) + r32m) + (w >> 1), him, false);
            __syncthreads();
            attn_finalize(accO, accL, AU, b, h, 2 * sc + ((j - 3) >> 1), tq);
            __syncthreads();
            if (j == 3) attn_merge(accO, accL, og2, lg2, r32m >= 16 ? 16 * (r32m - 16) + 2 * w : 16 * r32m + 2 * w + 1, him, true);
        }
        cur = nxt; klo = nklo; khi = nkhi; voff = nvoff;
    }
}

__device__ __forceinline__ void conv_unit(const bf16_t* U, const float* cw, const float* cb, const float* lnw, const float* lnb, bf16_t* AU, LAS unsigned char* scr, int unit) {
    int tid = threadIdx.x; asm volatile("" : "+v"(tid));
    const int lane = tid & 63, w = tid >> 6;
    const int b = unit >> 5, s0 = (unit & 31) * 64;
    const int cp = tid & 255, tg = tid >> 8;
    LAS float* cbuf = (LAS float*)scr;
    unsigned win[62];
#pragma unroll
    for (int i = 0; i < 62; ++i) { const int s = s0 + 32 * tg - 15 + i; win[i] = (s >= 0 && s < SEQ) ? *(const unsigned*)(U + (size_t)(b * SEQ + s) * CCH + 2 * cp) : 0u; }
    f32x2 acc[32];
    const f32x2 bias = *(const f32x2*)(cb + 2 * cp);
#pragma unroll
    for (int k = 0; k < 32; ++k) acc[k] = bias;
#pragma unroll
    for (int j = 0; j < CW; ++j) {
        const f32x2 wj = *(const f32x2*)(cw + j * CCH + 2 * cp);
#pragma unroll
        for (int k = 0; k < 32; ++k) { acc[k].x += wj.x * bf_lo(win[k + j]); acc[k].y += wj.y * bf_hi(win[k + j]); }
    }
#pragma unroll
    for (int k = 0; k < 32; ++k) *(LAS f32x2*)(cbuf + (32 * tg + k) * 516 + 2 * cp) = acc[k];
    __syncthreads();
    const f32x4 g0 = *(const f32x4*)(lnw + 4 * lane), g1 = *(const f32x4*)(lnw + 256 + 4 * lane), e0 = *(const f32x4*)(lnb + 4 * lane), e1 = *(const f32x4*)(lnb + 256 + 4 * lane);
    f32x4 va[8], vc[8]; float sm[8], sq[8];
#pragma unroll
    for (int k = 0; k < 8; ++k) { const int t = 8 * w + k;
        va[k] = *(const LAS f32x4*)(cbuf + t * 516 + 4 * lane); vc[k] = *(const LAS f32x4*)(cbuf + t * 516 + 256 + 4 * lane);
        sm[k] = (va[k][0] + va[k][1]) + (va[k][2] + va[k][3]) + (vc[k][0] + vc[k][1]) + (vc[k][2] + vc[k][3]); }
#pragma unroll
    for (int o = 1; o < 64; o <<= 1)
#pragma unroll
        for (int k = 0; k < 8; ++k) sm[k] += __shfl_xor(sm[k], o);
#pragma unroll
    for (int k = 0; k < 8; ++k) { const float mean = sm[k] * (1.0f / CCH); va[k] = va[k] - mean; vc[k] = vc[k] - mean;
        sq[k] = (va[k][0] * va[k][0] + va[k][1] * va[k][1]) + (va[k][2] * va[k][2] + va[k][3] * va[k][3]) + (vc[k][0] * vc[k][0] + vc[k][1] * vc[k][1]) + (vc[k][2] * vc[k][2] + vc[k][3] * vc[k][3]); }
#pragma unroll
    for (int o = 1; o < 64; o <<= 1)
#pragma unroll
        for (int k = 0; k < 8; ++k) sq[k] += __shfl_xor(sq[k], o);
#pragma unroll
    for (int k = 0; k < 8; ++k) {
        const int t = 8 * w + k;
        const float rstd = __builtin_amdgcn_rsqf(sq[k] * (1.0f / CCH) + EPS);
        f32x4 a = va[k] * rstd * g0 + e0, c = vc[k] * rstd * g1 + e1;
#pragma unroll
        for (int e = 0; e < 4; ++e) { a[e] = a[e] * sigmoidf_(a[e]); c[e] = c[e] * sigmoidf_(c[e]); }
        bf16_t* dst = AU + (size_t)(b * SEQ + s0 + t) * DM + CCH;
        u32x2 oa, oc; oa.x = cvtpk(a[0], a[1]); oa.y = cvtpk(a[2], a[3]); oc.x = cvtpk(c[0], c[1]); oc.y = cvtpk(c[2], c[3]);
        *(u32x2*)(dst + 4 * lane) = oa; *(u32x2*)(dst + 256 + 4 * lane) = oc;
    }
    __syncthreads();
}

__device__ __forceinline__ void p0_load(const float* W, int N, int k0, int cbase, const float* kscale, f32x4 (&v)[8], int lane) {
#pragma unroll
    for (int i = 0; i < 8; ++i) { const int kk = 8 * i + (lane >> 3); v[i] = *(const f32x4*)(W + (size_t)(k0 + kk) * N + cbase + 4 * (lane & 7)); if (kscale) v[i] = v[i] * kscale[k0 + kk]; }
}
__device__ __forceinline__ void p0_store(const f32x4 (&v)[8], int k0, bool qkperm, bf16_t* WT, int ldo, int kdst, int rho0, LAS float* scr, int lane) {
#pragma unroll
    for (int i = 0; i < 8; ++i) { LAS float* d = scr + (8 * i + (lane >> 3)) * 33 + 4 * (lane & 7); d[0] = v[i][0]; d[1] = v[i][1]; d[2] = v[i][2]; d[3] = v[i][3]; }
    LDS_WAIT(); asm volatile("" ::: "memory");
    const int c = lane & 7;
#pragma unroll
    for (int j = 0; j < 4; ++j) {
        const int n = (lane >> 3) + 8 * j;
        int src = perm32(n); if (qkperm) src = pos2dim(src);
        const LAS float* sp = scr + (8 * c) * 33 + src;
        u32x4 o; o.x = cvtpk(sp[0 * 33], sp[1 * 33]); o.y = cvtpk(sp[2 * 33], sp[3 * 33]); o.z = cvtpk(sp[4 * 33], sp[5 * 33]); o.w = cvtpk(sp[6 * 33], sp[7 * 33]);
        *(u32x4*)(WT + (size_t)(rho0 + n) * ldo + kdst + k0 + 8 * c) = o;
    }
    LDS_WAIT(); asm volatile("" ::: "memory");
}

struct Params {
    const float* x; const int* pos; const float *norm1_w, *w_in, *b_gate, *q_norm_w, *k_norm_w, *w_o_attn, *conv_w, *conv_b, *conv_ln_w, *conv_ln_b, *w_pw_conv, *w_out, *norm2_w, *w_ffn_in, *w_ffn_out;
    float* out; unsigned char* ws;
};

__constant__ double c_invfreq[8] = {1.0, 0.19392274474868576, 0.03760603093086393, 0.007292664737217109, 0.001414213562373095, 0.0002742481756762073, 5.318295896944988e-05, 1.031338537721246e-05};

constexpr int I_IN = 16 * (NIN / 32), I_O = 8 * 32, I_PW = 8 * 32, I_OUT = 16 * 32, I_F1 = 16 * (NF1 / 32), I_F2 = (DFF / 64) * 32;
constexpr int P0_NITEMS = I_IN + I_O + I_PW + I_OUT + I_F1 + I_F2;
template <bool LOAD>
__device__ __forceinline__ void p0_item(const Params& P, int it, f32x4 (&v)[8], LAS float* scr, int lane) {
    unsigned char* ws = P.ws;
    int r = it;
    if (r < I_IN) {
        const int kb = r / (NIN / 32), gi = r % (NIN / 32), rho0 = gi * 32;
        const int pn = rho0 >> 8, bj = (rho0 >> 7) & 1, wc = (rho0 >> 5) & 3;
        int cbase; bool qk = false;
        if (pn < 18) { const int sec = pn / 6, pt = pn - sec * 6, g = pt >> 1, head = 4 * (pt & 1) + wc; cbase = sec * QKVW + g * 512 + head * 64 + 32 * bj; qk = (sec < 2) && (bj == 0); }
        else if (pn < 22) cbase = 3 * QKVW + 512 * bj + (pn - 18) * 128 + 32 * wc;
        else cbase = 3 * QKVW + 1024 + (pn - 22) * 256 + 128 * bj + 32 * wc;
        if (LOAD) p0_load(P.w_in, NIN, kb * 64, cbase, nullptr, v, lane); else p0_store(v, kb * 64, qk, (bf16_t*)(ws + WS_WIN), DM, 0, rho0, scr, lane);
        return; }
    r -= I_IN;
    if (r < I_O) { const int kb = r / 32, gi = r % 32; if (LOAD) p0_load(P.w_o_attn, DM, kb * 64, gi * 32, nullptr, v, lane); else p0_store(v, kb * 64, false, (bf16_t*)(ws + WS_WCAT), DM, 0, gi * 32, scr, lane); return; }
    r -= I_O;
    if (r < I_PW) { const int kb = r / 32, gi = r % 32; if (LOAD) p0_load(P.w_pw_conv, DM, kb * 64, gi * 32, nullptr, v, lane); else p0_store(v, kb * 64, false, (bf16_t*)(ws + WS_WCAT), DM, 512, gi * 32, scr, lane); return; }
    r -= I_PW;
    if (r < I_OUT) { const int kb = r / 32, gi = r % 32; if (LOAD) p0_load(P.w_out, DM, kb * 64, gi * 32, nullptr, v, lane); else p0_store(v, kb * 64, false, (bf16_t*)(ws + WS_WOUT), DM, 0, gi * 32, scr, lane); return; }
    r -= I_OUT;
    if (r < I_F1) {
        const int kb = r / (NF1 / 32), gi = r % (NF1 / 32), rho0 = gi * 32;
        const int pn = rho0 >> 8, bj = (rho0 >> 7) & 1, wc = (rho0 >> 5) & 3;
        if (LOAD) p0_load(P.w_ffn_in, NF1, kb * 64, DFF * bj + 128 * pn + 32 * wc, P.norm2_w, v, lane); else p0_store(v, kb * 64, false, (bf16_t*)(ws + WS_WF1), DM, 0, rho0, scr, lane);
        return; }
    r -= I_F1;
    { const int kb = r / 32, gi = r % 32; if (LOAD) p0_load(P.w_ffn_out, DM, kb * 64, gi * 32, nullptr, v, lane); else p0_store(v, kb * 64, false, (bf16_t*)(ws + WS_WF2), DFF, 0, gi * 32, scr, lane); }
}

__device__ __forceinline__ void p0_weights(const Params& P, LAS float* scr, int lane, int iw, int nw, int lo, int hi) {
    f32x4 va[8], vb[8];
    int it = lo + iw;
    if (it < hi) p0_item<true>(P, it, va, scr, lane);
    while (it < hi) {
        const int nx = it + nw;
        if (nx < hi) p0_item<true>(P, nx, vb, scr, lane);
        p0_item<false>(P, it, va, scr, lane);
        it = nx;
        if (it >= hi) break;
        const int nx2 = it + nw;
        if (nx2 < hi) p0_item<true>(P, nx2, va, scr, lane);
        p0_item<false>(P, it, vb, scr, lane);
        it = nx2;
    }
}
__device__ __forceinline__ void p0_prologue(const Params& P, LAS unsigned char* scrb, int vcu, int G) {
    int tid = threadIdx.x; asm volatile("" : "+v"(tid));
    const int lane = tid & 63, wave = tid >> 6;
    LAS float* scr = (LAS float*)(scrb + wave * 16384);
    const int gw = vcu * 8 + wave, NGW = G * 8;
    unsigned char* ws = P.ws;
    bf16_t* Hn = (bf16_t*)((unsigned char*)P.out + DO_H);
    { f32x4 nw[4];
#pragma unroll
      for (int j = 0; j < 4; ++j) nw[j] = *((const f32x4*)P.norm1_w + lane + 64 * j);
      for (int m0 = gw; m0 < MTOK; m0 += 4 * NGW) {
        f32x4 v[4][4];
#pragma unroll
        for (int q = 0; q < 4; ++q) { const int m = m0 + q * NGW; if (m < MTOK) { const f32x4* xr = (const f32x4*)(P.x + (size_t)m * DM) + lane;
#pragma unroll
            for (int j = 0; j < 4; ++j) v[q][j] = xr[64 * j]; } }
#pragma unroll
        for (int q = 0; q < 4; ++q) { const int m = m0 + q * NGW; if (m < MTOK) {
            float s = 0.f;
#pragma unroll
            for (int j = 0; j < 4; ++j) s += (v[q][j][0] * v[q][j][0] + v[q][j][1] * v[q][j][1]) + (v[q][j][2] * v[q][j][2] + v[q][j][3] * v[q][j][3]);
            const float rstd = __builtin_amdgcn_rsqf(wave_sum(s) * (1.0f / DM) + EPS);
            u32x2* o8 = (u32x2*)(Hn + (size_t)m * DM) + lane;
#pragma unroll
            for (int j = 0; j < 4; ++j) { const f32x4 y = v[q][j] * rstd * nw[j]; u32x2 o; o.x = cvtpk(y[0], y[1]); o.y = cvtpk(y[2], y[3]); o8[64 * j] = o; } } }
      } }
    p0_weights(P, scr, lane, gw, NGW, 0, I_IN);
    float* rope = (float*)(ws + WS_ROPE);
    for (int i = vcu * 512 + tid; i < MTOK * 8; i += G * 512) {
        const int tok = i >> 3, f = i & 7;
        const double ang = (double)P.pos[tok] * c_invfreq[f];
        const double kq = __builtin_rint(ang * 0.15915494309189535);
        const double xr = __builtin_fma(-kq, 6.283185307179586, ang) - kq * 2.4492935982947064e-16;
        const double x2 = xr * xr;
        double sn = 1.0, cs = 1.0;
#pragma unroll
        for (int n = 12; n >= 1; --n) { sn = 1.0 - sn * x2 / (double)((2 * n) * (2 * n + 1)); cs = 1.0 - cs * x2 / (double)((2 * n - 1) * (2 * n)); }
        sn *= xr;
        rope[(size_t)tok * 16 + f] = (float)cs; rope[(size_t)tok * 16 + 8 + f] = (float)sn;
    }
}

#define RLX_AGENT __ATOMIC_RELAXED, __HIP_MEMORY_SCOPE_AGENT
#define XB_TMO      128
#define XB_XCNT(j)  (256  + 64 * (j))
#define XB_XSUB(j)  (1280 + 64 * (j))
#define XB_XGEN(j)  (2304 + 64 * (j))
#define XB_TOP      3328
#define XB_TOPGEN   3392
#define XCD_BAR_WORDS 3456
#define XB_SPIN_CAP (1u << 18)
__device__ __forceinline__ unsigned xb_ld(unsigned* p)              { return __hip_atomic_load(p, __ATOMIC_RELAXED, __HIP_MEMORY_SCOPE_AGENT); }
__device__ __forceinline__ unsigned xb_add(unsigned* p, unsigned v) { return __hip_atomic_fetch_add(p, v, __ATOMIC_RELAXED, __HIP_MEMORY_SCOPE_AGENT); }
__device__ __forceinline__ unsigned xb_xcc_id() { return (unsigned)__builtin_amdgcn_s_getreg((3 << 11) | 20) & 0xFu; }
#define XB_SPIN(cond, bar) do { unsigned _sp = 0; while (cond) { __builtin_amdgcn_s_sleep(1); \
    if ((++_sp & 255u) == 0u) { if (xb_ld(&(bar)[XB_TMO])) break; if (_sp > XB_SPIN_CAP) { atomicAdd(&(bar)[XB_TMO], 1u); break; } } } } while (0)
struct XcdBarrier { unsigned* bar; unsigned x; volatile LAS unsigned* st; };
__device__ __forceinline__ XcdBarrier xcd_barrier_post(unsigned* bar, volatile LAS unsigned* st) {
    XcdBarrier b; b.bar = bar; b.x = xb_xcc_id(); b.st = st;
    if (threadIdx.x == 0) (void)xb_add(&bar[XB_XCNT(b.x)], 1u);
    return b;
}
__device__ __forceinline__ void xcd_barrier_complete(unsigned* bar, unsigned x, unsigned& nloc, unsigned& nx) {
    const unsigned G = gridDim.x * gridDim.y * gridDim.z;
    unsigned sum, cnt, mine, sp = 0u;
    for (;;) {
        sum = 0u; cnt = 0u; mine = 0u;
#pragma unroll
        for (unsigned j = 0; j < 16; ++j) { const unsigned c = xb_ld(&bar[XB_XCNT(j)]); sum += c; cnt += (c > 0u) ? 1u : 0u; mine = (j == x) ? c : mine; }
        if (sum == G) break;
        __builtin_amdgcn_s_sleep(1);
        if ((++sp & 255u) == 0u) { if (xb_ld(&bar[XB_TMO])) break; if (sp > XB_SPIN_CAP) { atomicAdd(&bar[XB_TMO], 1u); break; } }
    }
    nloc = mine > 0u ? mine : 1u; nx = cnt > 0u ? cnt : 1u;
}
__device__ __forceinline__ void xcd_barrier(const XcdBarrier& b) {
    asm volatile("s_waitcnt vmcnt(0)" ::: "memory");
    __syncthreads();
    if (threadIdx.x == 0) {
        unsigned* bar = b.bar;
        __builtin_amdgcn_s_waitcnt(0);
        unsigned nloc = b.st[0], nx = b.st[1];
        if (nloc == 0u) { xcd_barrier_complete(bar, b.x, nloc, nx); b.st[0] = nloc; b.st[1] = nx; }
        const unsigned old = xb_add(&bar[XB_XSUB(b.x)], 1u);
        const unsigned gen = old / nloc;
        if (old + 1u == (gen + 1u) * nloc) {
            __builtin_amdgcn_fence(__ATOMIC_RELEASE, "agent");
            asm volatile("s_waitcnt vmcnt(0)" ::: "memory");
            const unsigned og = xb_add(&bar[XB_TOP], 1u);
            const unsigned tg = og / nx;
            if (og + 1u == (tg + 1u) * nx) xb_add(&bar[XB_TOPGEN], 1u);
            else XB_SPIN(xb_ld(&bar[XB_TOPGEN]) == tg, bar);
            __builtin_amdgcn_fence(__ATOMIC_ACQUIRE, "agent");
            xb_add(&bar[XB_XGEN(b.x)], 1u);
            asm volatile("s_waitcnt vmcnt(0)" ::: "memory");
        } else {
            XB_SPIN(xb_ld(&bar[XB_XGEN(b.x)]) == gen, bar);
            __builtin_amdgcn_fence(__ATOMIC_ACQUIRE, "agent");
            asm volatile("s_waitcnt vmcnt(0)" ::: "memory");
        }
    }
    __syncthreads();
}

#ifndef REP_P0
#define REP_P0 1
#endif
#ifndef REP_P1
#define REP_P1 1
#endif
#ifndef REP_P2A
#define REP_P2A 1
#endif
#ifndef REP_P2C
#define REP_P2C 1
#endif
#ifndef REP_P3A
#define REP_P3A 1
#endif
#ifndef REP_P3B
#define REP_P3B 1
#endif
#ifndef REP_P3C
#define REP_P3C 1
#endif
#ifndef REP_P3D
#define REP_P3D 1
#endif
#ifndef PROBE_SPIN
#define PROBE_SPIN 0
#endif
#ifndef EXTRA_SYNC
#define EXTRA_SYNC 0
#endif
__global__ void __launch_bounds__(512, 2) fwd_kernel(Params P) {
    extern __shared__ __attribute__((aligned(16))) unsigned char lds_raw[];
    LAS unsigned char* lds = (LAS unsigned char*)lds_raw;
    LAS unsigned char* scr = lds + LDS_SCR;
    const int G = gridDim.x, bx = blockIdx.x;
    const int vcu = (G % 8 == 0) ? (bx % 8) * (G / 8) + bx / 8 : bx;
    unsigned char* ws = P.ws; unsigned char* ob = (unsigned char*)P.out;
    bf16_t* Qb = (bf16_t*)(ws + WS_Q); bf16_t* Kb = (bf16_t*)(ws + WS_K); bf16_t* Vb = (bf16_t*)(ws + WS_V); bf16_t* Gt = (bf16_t*)(ws + WS_GATE);
    bf16_t* Ub = (bf16_t*)(ob + DO_U); bf16_t* AU = (bf16_t*)(ob + DO_AU); bf16_t* Hn = (bf16_t*)(ob + DO_H);
    float* SSQ = (float*)(ws + WS_SSQ);

    if (threadIdx.x < 64) ((LAS unsigned*)(lds + LDS_MISC))[threadIdx.x] = 0u;
    __syncthreads();
    const XcdBarrier xbar = xcd_barrier_post((unsigned*)(ws + WS_CTL) + 4096, (volatile LAS unsigned*)(lds + LDS_MISC) + 8);
    unsigned long long tprev = PROBE_SPIN ? __builtin_amdgcn_s_memrealtime() : 0ull;
#define SEAM(k, dosync) do { if (dosync) xcd_barrier(xbar); if (PROBE_SPIN) { const unsigned long long now_ = __builtin_amdgcn_s_memrealtime(); \
        if (PROBE_SPIN == (k)) { const unsigned long long d_ = now_ - tprev; while (__builtin_amdgcn_s_memrealtime() - now_ < d_) __builtin_amdgcn_s_sleep(8); } \
        tprev = __builtin_amdgcn_s_memrealtime(); } } while (0)
    for (int rep = 0; rep < REP_P0; ++rep) p0_prologue(P, scr, vcu, G);
    for (int rep = 0; rep < EXTRA_SYNC; ++rep) xcd_barrier(xbar);
    SEAM(1, 1);

    { pg8::Gemm g{Hn, (const bf16_t*)(ws + WS_WIN), DM, DM, DM, 0}; pg8::StaticOrder S; S.init(MTOK, NIN, G, bx);
      EpiIn E{Qb, Kb, Vb, Ub, Gt, P.q_norm_w, P.k_norm_w, P.b_gate, (const float*)(ws + WS_ROPE)};
      for (int rep = 0; rep < REP_P1; ++rep) pg8::gemm_phase(scr, g, S, E);
      const int nun = (MTOK / 256) * (NIN / 256), rem = nun % G, nidle = rem ? G - rem : G, iw = rem ? bx - rem : bx;
      if (iw >= 0) { int tid = threadIdx.x; asm volatile("" : "+v"(tid));
          p0_weights(P, (LAS float*)(scr + (tid >> 6) * 16384), tid & 63, iw * 8 + (tid >> 6), nidle * 8, I_IN, P0_NITEMS); } }
    SEAM(2, 1);

    { float qm = 0.f, km = 0.f;
      for (int i = 0; i < HD; ++i) { qm = fmaxf(qm, fabsf(P.q_norm_w[i])); km = fmaxf(km, fabsf(P.k_norm_w[i])); }
      const float negc = -fminf(8.0f * qm * km * LOG2E, 60.0f);
      for (int rep = 0; rep < REP_P2A; ++rep) for (int it = vcu; it < BATCH * NHEAD * 4; it += G) attn_super(Qb, Kb, Vb, AU, negc, scr, it);
      for (int rep = 0; rep < REP_P2C; ++rep) for (int un = vcu; un < BATCH * 32; un += G) conv_unit(Ub, P.conv_w, P.conv_b, P.conv_ln_w, P.conv_ln_b, AU, scr, un); }
    SEAM(3, 1);

    { pg8::Gemm g{AU, (const bf16_t*)(ws + WS_WCAT), DM, DM, 512, 512}; pg8::StaticOrder S; S.init(MTOK, DM, G, bx, 2);
      EpiMix E{Gt, (bf16_t*)(ws + WS_Z)};
      for (int rep = 0; rep < REP_P3A; ++rep) pg8::gemm_phase(scr, g, S, E); }
    SEAM(4, 1);

    { pg8::Gemm g{(const bf16_t*)(ws + WS_Z), (const bf16_t*)(ws + WS_WOUT), DM, DM, DM, 0}; pg8::StaticOrder S; S.init(MTOK, DM, G, bx);
      EpiOut E{P.x, (bf16_t*)(ws + WS_X1B), SSQ};
      for (int rep = 0; rep < REP_P3B; ++rep) pg8::gemm_phase(scr, g, S, E); }
    SEAM(5, 1);

    { pg8::Gemm g{(const bf16_t*)(ws + WS_X1B), (const bf16_t*)(ws + WS_WF1), DM, DM, DM, 0}; pg8::StaticOrder S; S.init(MTOK, NF1, G, bx);
      EpiFfn1 E{SSQ, (bf16_t*)(ws + WS_ACT)};
      for (int rep = 0; rep < REP_P3C; ++rep) pg8::gemm_phase(scr, g, S, E); }
    SEAM(6, 1);

    { pg8::Gemm g{(const bf16_t*)(ws + WS_ACT), (const bf16_t*)(ws + WS_WF2), DFF, DFF, DFF, 0}; pg8::StaticOrder S; S.init(MTOK, DM, G, bx);
      for (int rep = 1; rep < REP_P3D; ++rep) { EpiFfn2 E0{(const bf16_t*)(ws + WS_X1B), (float*)(ws + WS_GATE)}; pg8::gemm_phase(scr, g, S, E0); }
      EpiFfn2 E{(const bf16_t*)(ws + WS_X1B), P.out};
      pg8::gemm_phase(scr, g, S, E); }
    SEAM(7, 0);
}

extern "C" void kernel_launch(void* const* d_in, const int* in_sizes, int n_in, void* d_out, int out_size, void* d_ws, size_t ws_size, hipStream_t stream) {
    static int grid = 0;
    if (grid == 0) {
        if (n_in != 17 || out_size != MTOK * DM || ws_size < WS_END) { fprintf(stderr, "kernel_launch: unexpected shapes (n_in %d out %d ws %zu)\n", n_in, out_size, ws_size); grid = -1; return; }
        int dev = 0, cus = 0, per_cu = 0;
        hipGetDevice(&dev);
        hipDeviceGetAttribute(&cus, hipDeviceAttributeMultiprocessorCount, dev);
        hipFuncSetAttribute((const void*)fwd_kernel, hipFuncAttributeMaxDynamicSharedMemorySize, LDS_BYTES);
        hipOccupancyMaxActiveBlocksPerMultiprocessor(&per_cu, (const void*)fwd_kernel, 512, LDS_BYTES);
        if (per_cu < 1) { fprintf(stderr, "kernel_launch: occupancy query says %d blocks per CU\n", per_cu); grid = -1; return; }
        grid = cus * (per_cu < 1 ? 0 : 1);
        fprintf(stderr, "kernel_launch: grid %d (occupancy %d per CU)\n", grid, per_cu);
    }
    if (grid < 0) return;
    Params p{};
    p.x = (const float*)d_in[0]; p.pos = (const int*)d_in[1]; p.norm1_w = (const float*)d_in[2]; p.w_in = (const float*)d_in[3]; p.b_gate = (const float*)d_in[4];
    p.q_norm_w = (const float*)d_in[5]; p.k_norm_w = (const float*)d_in[6]; p.w_o_attn = (const float*)d_in[7]; p.conv_w = (const float*)d_in[8]; p.conv_b = (const float*)d_in[9];
    p.conv_ln_w = (const float*)d_in[10]; p.conv_ln_b = (const float*)d_in[11]; p.w_pw_conv = (const float*)d_in[12]; p.w_out = (const float*)d_in[13]; p.norm2_w = (const float*)d_in[14];
    p.w_ffn_in = (const float*)d_in[15]; p.w_ffn_out = (const float*)d_in[16]; p.out = (float*)d_out; p.ws = (unsigned char*)d_ws;
    if (hipMemsetAsync((char*)d_ws + WS_CTL, 0, CTL_BYTES, stream) != hipSuccess) { fprintf(stderr, "kernel_launch: memset failed\n"); return; }
    void* args[] = {&p};
    hipError_t e = hipLaunchCooperativeKernel((const void*)fwd_kernel, dim3(grid), dim3(512), args, LDS_BYTES, stream);
    if (e != hipSuccess) fprintf(stderr, "cooperative launch failed: %s (grid %d)\n", hipGetErrorString(e), grid);
}
```

```cpp
#include <hip/hip_runtime.h>
#include <hip/hip_cooperative_groups.h>
#include <cstdio>
#include <cstdint>
namespace cg = cooperative_groups;

#define LAS __attribute__((address_space(3)))
#define GAS __attribute__((address_space(1)))
typedef unsigned short bf16_t;
typedef short bf16x8 __attribute__((ext_vector_type(8)));
typedef short s16x4 __attribute__((ext_vector_type(4)));
typedef float f32x4 __attribute__((ext_vector_type(4)));
typedef float f32x2 __attribute__((ext_vector_type(2)));
typedef float f32x16 __attribute__((ext_vector_type(16)));
typedef unsigned u32x4 __attribute__((ext_vector_type(4)));
typedef unsigned u32x2 __attribute__((ext_vector_type(2)));
typedef __bf16 bf16x2_t __attribute__((ext_vector_type(2)));

constexpr int BATCH = 8, SEQ = 2048, DM = 1024, MTOK = BATCH * SEQ;
constexpr int NIN = 7680, DFF = 2816, NF1 = 2 * DFF;
constexpr int NGRP = 3, NHEAD = 8, HD = 64, QKVW = 1536, CCH = 512, CW = 31;
constexpr float EPS = 1e-6f;
constexpr float LOG2E = 1.4426950408889634f;
constexpr float QSCALE = 0.125f * LOG2E;

constexpr size_t MiB = 1u << 20;
constexpr size_t WS_CTL = 0, CTL_BYTES = 64 * 1024;
constexpr size_t WS_WIN = 1 * MiB;
constexpr size_t WS_WCAT = 16 * MiB;
constexpr size_t WS_WOUT = 18 * MiB;
constexpr size_t WS_WF1 = 20 * MiB;
constexpr size_t WS_WF2 = 31 * MiB;
constexpr size_t WS_SSQ = 37 * MiB;
constexpr size_t WS_ROPE = 38 * MiB;
constexpr size_t WS_Q = 40 * MiB;
constexpr size_t WS_K = 88 * MiB;
constexpr size_t WS_V = 136 * MiB;
constexpr size_t WS_GATE = 184 * MiB;
constexpr size_t WS_T = 40 * MiB;
constexpr size_t WS_Z = 104 * MiB;
constexpr size_t WS_X1B = 40 * MiB;
constexpr size_t WS_ACT = 72 * MiB;
constexpr size_t WS_END = 248 * MiB;
constexpr size_t DO_H = 0;
constexpr size_t DO_U = 32 * MiB;
constexpr size_t DO_AU = 0;

constexpr int LDS_MISC = 0, LDS_SCR = 1024, LDS_BYTES = 1024 + 139264;

__device__ __forceinline__ unsigned cvtpk(float lo, float hi) { f32x2 v = {lo, hi}; bf16x2_t b = __builtin_convertvector(v, bf16x2_t); return __builtin_bit_cast(unsigned, b); }
__device__ __forceinline__ float bf_lo(unsigned w) { return __uint_as_float(w << 16); }
__device__ __forceinline__ float bf_hi(unsigned w) { return __uint_as_float(w & 0xffff0000u); }
__device__ __forceinline__ float sigmoidf_(float x) { return __builtin_amdgcn_rcpf(1.0f + __builtin_amdgcn_exp2f(-x * LOG2E)); }
__device__ __forceinline__ float wave_sum(float v) {
#pragma unroll
    for (int o = 1; o < 64; o <<= 1) v += __shfl_xor(v, o);
    return v;
}
#define LDS_WAIT() asm volatile("s_waitcnt lgkmcnt(0)" ::: "memory")
#define VM_WAIT() asm volatile("s_waitcnt vmcnt(0)" ::: "memory")

__host__ __device__ __forceinline__ int pos2dim(int p) { return p < 16 ? (4 * (p >> 3) + 8 * ((p >> 2) & 1) + (p & 3)) : p; }
__host__ __device__ __forceinline__ int perm32(int rho) { const int n = rho >> 4, i = rho & 15; return 8 * (i >> 2) + 4 * n + (i & 3); }

namespace pg8 {
constexpr int BM = 256, BK = 64, HALF = 128, HTB = HALF * BK * 2, STAGE_BYTES = 8 * HTB, NXCD = 8, WGM = 4;
__host__ __device__ __forceinline__ int lds_byte(int r, int c) { const int st = (r >> 4) * 2 + (c >> 5), rr = r & 15, cc = c & 31, ob = rr * 64 + cc * 2; return st * 1024 + (ob ^ (((ob >> 9) & 1) << 5)); }
__host__ __device__ __forceinline__ void stage_rc(int b, int& R, int& C) { const int st = b / 1024, sb = b % 1024, swz = sb ^ (((sb >> 9) & 1) << 5); R = (st >> 1) * 16 + swz / 64; C = (st & 1) * 32 + (swz % 64) / 2; }

struct Unit { int pm, pn, kind; };
struct Gemm { const bf16_t* A; const bf16_t* Bt; int lda, ldb, K, koff; };

struct StaticOrder {
    int nM, nN, nwg, G, c, nkind;
    __device__ void init(int M, int N, int G_, int c_, int nkind_ = 1) { nM = M / BM; nN = N / BM; nwg = nM * nN; G = G_; c = c_; nkind = nkind_; }
    __device__ bool tile(long L, Unit& u) const {
        if (L >= nwg) return false;
        int wgid = (int)L; { const int q = nwg / NXCD, r = nwg % NXCD, xcd = wgid % NXCD, off = wgid / NXCD; wgid = (xcd < r ? xcd * (q + 1) : r * (q + 1) + (xcd - r) * q) + off; }
        const int nig = WGM * nN, gid = wgid / nig, fm = gid * WGM, gsz = (nM - fm) < WGM ? (nM - fm) : WGM;
        u.pm = fm + ((wgid % nig) % gsz); u.pn = (wgid % nig) / gsz; return true;
    }
    __device__ bool next(int i, Unit& u) const {
        if (nkind == 1) { u.kind = 0; return tile((long)i * G + c, u); }
        u.kind = i & 1; return tile((long)(i >> 1) * G + c, u);
    }
};

template <class Epi, class Sched>
__device__ __forceinline__ void gemm_phase(LAS unsigned char* lds, const Gemm g, const Sched& S, const Epi& E) {
    int tid = threadIdx.x; asm volatile("" : "+v"(tid));
    const int wid = __builtin_amdgcn_readfirstlane(tid >> 6), lane = tid & 63, wr = wid >> 2, wc = wid & 3, fr = lane & 15, fq = lane >> 4;
    const int nt = g.K / BK;
    unsigned voffA[2], voffB[2];
#pragma unroll
    for (int i = 0; i < 2; ++i) { int R, C; stage_rc(tid * 16 + i * 8192, R, C); voffA[i] = (unsigned)(R * g.lda + C) * 2u; voffB[i] = (unsigned)(R * g.ldb + C) * 2u; }
    const size_t kstep = (size_t)(BK * 2);
    const size_t hstepA = (size_t)HALF * g.lda * 2, hstepB = (size_t)HALF * g.ldb * 2;
    const size_t tstepA = 2 * hstepA, tstepB = 2 * hstepB;
    const unsigned ldsw = (unsigned)wid * 1024u;
    const int aoff = lds_byte(wr * 64 + fr, fq * 8), boff = lds_byte(wc * 32 + fr, fq * 8);
#define PG8_SA(b, h) (((b) * 2 + (h)) * HTB)
#define PG8_SB(b, h) ((4 + (b) * 2 + (h)) * HTB)
#define PG8_STAGE(bufoff, gbase, voff) do { _Pragma("unroll") for (int _i = 0; _i < 2; ++_i) \
        __builtin_amdgcn_global_load_lds((const unsigned*)((const char*)(gbase) + (voff)[_i]), (LAS unsigned*)(lds + (bufoff) + ldsw + _i * 8192), 16, 0, 0); } while (0)
#define PG8_LDA(dst, b, h) do { _Pragma("unroll") for (int m = 0; m < 4; ++m) _Pragma("unroll") for (int k = 0; k < 2; ++k) dst[m][k] = *(const LAS bf16x8*)(lds + PG8_SA(b, h) + aoff + m * 2048 + k * 1024); } while (0)
#define PG8_LDB(dst, b, h) do { _Pragma("unroll") for (int n = 0; n < 2; ++n) _Pragma("unroll") for (int k = 0; k < 2; ++k) dst[n][k] = *(const LAS bf16x8*)(lds + PG8_SB(b, h) + boff + n * 2048 + k * 1024); } while (0)
#define PG8_MMA(ai, bj, At, Bt) do { __builtin_amdgcn_s_setprio(1); _Pragma("unroll") for (int m = 0; m < 4; ++m) _Pragma("unroll") for (int n = 0; n < 2; ++n) _Pragma("unroll") for (int k = 0; k < 2; ++k) \
        acc[ai][bj][m][n] = __builtin_amdgcn_mfma_f32_16x16x32_bf16(Bt[n][k], At[m][k], acc[ai][bj][m][n], 0, 0, 0); __builtin_amdgcn_s_setprio(0); } while (0)
#define PG8_WAIT_V(n) asm volatile("s_waitcnt vmcnt(" #n ")" ::: "memory")
#define PG8_WAIT_L(n) asm volatile("s_waitcnt lgkmcnt(" #n ")" ::: "memory")
#define PG8_BAR __builtin_amdgcn_s_barrier()
#define PG8_SCHED __builtin_amdgcn_sched_barrier(0)
    Unit cur, nxt; int ui = 0;
    if (!S.next(0, cur)) return;
    f32x4 acc[2][2][4][2];
#pragma unroll
    for (int a = 0; a < 2; ++a)
#pragma unroll
        for (int b = 0; b < 2; ++b)
#pragma unroll
            for (int m = 0; m < 4; ++m)
#pragma unroll
                for (int n = 0; n < 2; ++n) acc[a][b][m][n] = (f32x4){0.f, 0.f, 0.f, 0.f};
    bf16x8 At[4][2], B0[2][2], B1[2][2];
    const char* cA = (const char*)g.A + (size_t)cur.pm * tstepA + (size_t)cur.kind * g.koff * 2;
    const char* cB = (const char*)g.Bt + (size_t)cur.pn * tstepB + (size_t)cur.kind * g.koff * 2;
    PG8_STAGE(PG8_SB(0, 0), cB, voffB); PG8_STAGE(PG8_SB(0, 1), cB + hstepB, voffB); PG8_STAGE(PG8_SA(0, 0), cA, voffA); PG8_STAGE(PG8_SA(0, 1), cA + hstepA, voffA);
    if (wr == 1) PG8_BAR;
    PG8_WAIT_V(2); PG8_BAR;
    PG8_STAGE(PG8_SB(1, 0), cB + kstep, voffB); PG8_STAGE(PG8_SA(1, 0), cA + kstep, voffA); PG8_STAGE(PG8_SB(1, 1), cB + hstepB + kstep, voffB);
    PG8_WAIT_V(6); PG8_BAR;
    for (;;) {
        const bool has_next = S.next(ui + 1, nxt);
        const char* nA = has_next ? (const char*)g.A + (size_t)nxt.pm * tstepA + (size_t)nxt.kind * g.koff * 2 : cA;
        const char* nB = has_next ? (const char*)g.Bt + (size_t)nxt.pn * tstepB + (size_t)nxt.kind * g.koff * 2 : cB;
        for (int t = 0; t < nt; t += 2) {
            const bool last = (t == nt - 2);
            const char* a1 = cA + (size_t)(t + 1) * kstep;
            const char* a2 = last ? nA : cA + (size_t)(t + 2) * kstep; const char* b2 = last ? nB : cB + (size_t)(t + 2) * kstep;
            const char* a3 = a2 + kstep; const char* b3 = b2 + kstep;
            PG8_LDB(B0, 0, 0); PG8_LDB(B1, 0, 1); PG8_SCHED; PG8_LDA(At, 0, 0); PG8_STAGE(PG8_SA(1, 1), a1 + hstepA, voffA);
            PG8_WAIT_V(8); PG8_WAIT_L(0); PG8_BAR; PG8_MMA(0, 0, At, B0); PG8_MMA(0, 1, At, B1); PG8_BAR; PG8_SCHED;
            PG8_LDA(At, 0, 1); PG8_STAGE(PG8_SB(0, 0), b2, voffB); PG8_STAGE(PG8_SB(0, 1), b2 + hstepB, voffB); PG8_STAGE(PG8_SA(0, 0), a2, voffA);
            PG8_WAIT_V(8); PG8_WAIT_L(0); PG8_BAR; PG8_MMA(1, 0, At, B0); PG8_MMA(1, 1, At, B1); PG8_BAR; PG8_SCHED;
            PG8_LDB(B0, 1, 0); PG8_LDB(B1, 1, 1); PG8_SCHED; PG8_LDA(At, 1, 0); PG8_STAGE(PG8_SA(0, 1), a2 + hstepA, voffA);
            PG8_WAIT_V(8); PG8_WAIT_L(0); PG8_BAR; PG8_MMA(0, 0, At, B0); PG8_MMA(0, 1, At, B1); PG8_BAR; PG8_SCHED;
            PG8_LDA(At, 1, 1); PG8_STAGE(PG8_SB(1, 0), b3, voffB); PG8_STAGE(PG8_SB(1, 1), b3 + hstepB, voffB); PG8_STAGE(PG8_SA(1, 0), a3, voffA);
            PG8_WAIT_V(8); PG8_WAIT_L(0); PG8_BAR; PG8_MMA(1, 0, At, B0); PG8_MMA(1, 1, At, B1); PG8_BAR; PG8_SCHED;
        }
        if (wr == 0) PG8_BAR;
        const bool keep = E(acc, cur, wr, wc, fr, fq);
        if (!has_next) break;
        if (!keep)
#pragma unroll
        for (int a = 0; a < 2; ++a)
#pragma unroll
            for (int b = 0; b < 2; ++b)
#pragma unroll
                for (int m = 0; m < 4; ++m)
#pragma unroll
                    for (int n = 0; n < 2; ++n) acc[a][b][m][n] = (f32x4){0.f, 0.f, 0.f, 0.f};
        cur = nxt; cA = nA; cB = nB; ++ui;
        if (wr == 1) PG8_BAR;
    }
    PG8_WAIT_V(0);
    PG8_BAR;
#undef PG8_SA
#undef PG8_SB
#undef PG8_STAGE
#undef PG8_LDA
#undef PG8_LDB
#undef PG8_MMA
#undef PG8_WAIT_V
#undef PG8_WAIT_L
#undef PG8_BAR
#undef PG8_SCHED
}
}

typedef f32x4 AccT[2][2][4][2];

struct EpiIn {
    bf16_t *Q, *Kb, *V, *U, *G; const float *qnw, *knw, *bgate, *rope;
    __device__ __forceinline__ bool operator()(AccT& acc, const pg8::Unit& u, int wr, int wc, int fr, int fq) const {
        const int pn = u.pn, tok0 = u.pm * 256 + wr * 64 + fr;
        if (pn < 18) {
            const int sec = pn / 6, pt = pn - sec * 6, g = pt >> 1, head = 4 * (pt & 1) + wc;
            const int dsh = 2 * g, Lg = SEQ >> dsh;
            bf16_t* dst = Q + (size_t)sec * ((WS_K - WS_Q) / 2);
            const float* nw = qnw; if (sec == 1) nw = knw;
            if (sec < 2) {
                const int d00 = fq < 2 ? 4 * fq : 8 * fq, d01 = fq < 2 ? 4 * fq + 8 : 8 * fq + 4;
                const f32x4 w00 = *(const f32x4*)(nw + d00), w01 = *(const f32x4*)(nw + d01), w10 = *(const f32x4*)(nw + 32 + 8 * fq), w11 = *(const f32x4*)(nw + 36 + 8 * fq);
                const float sc = sec == 0 ? QSCALE : 1.0f;
                const int fo = fq < 2 ? 4 * fq : 0;
#pragma unroll
                for (int ai = 0; ai < 2; ++ai) {
                    f32x4 csv[4], snv[4];
#pragma unroll
                    for (int m = 0; m < 4; ++m) { const float* rp = rope + (size_t)(tok0 + ai * 128 + m * 16) * 16 + fo; csv[m] = *(const f32x4*)rp; snv[m] = *(const f32x4*)(rp + 8); }
#pragma unroll
                    for (int m = 0; m < 4; ++m) {
                        const int tok = tok0 + ai * 128 + m * 16, b = tok >> 11, s = tok & (SEQ - 1);
                        f32x4 v00 = acc[ai][0][m][0], v01 = acc[ai][0][m][1], v10 = acc[ai][1][m][0], v11 = acc[ai][1][m][1];
                        float ss = 0.f;
#pragma unroll
                        for (int e = 0; e < 4; ++e) ss += v00[e] * v00[e] + v01[e] * v01[e] + v10[e] * v10[e] + v11[e] * v11[e];
                        ss += __shfl_xor(ss, 16); ss += __shfl_xor(ss, 32);
                        const float rstd = __builtin_amdgcn_rsqf(ss * (1.0f / 64.0f) + EPS);
                        v00 = v00 * rstd * w00; v01 = v01 * rstd * w01; v10 = v10 * rstd * w10; v11 = v11 * rstd * w11;
                        const f32x4 cs = csv[m], sn = snv[m];
                        const f32x4 t1 = v00 * cs - v01 * sn, t2 = v01 * cs + v00 * sn;
                        if (fq < 2) { v00 = t1; v01 = t2; }
                        v00 = v00 * sc; v01 = v01 * sc; v10 = v10 * sc; v11 = v11 * sc;
                        const size_t row = (size_t)((b * NGRP + g) * NHEAD + head) * SEQ + (size_t)(s & ((1 << dsh) - 1)) * Lg + (s >> dsh);
                        bf16_t* p = dst + row * HD + 8 * fq;
                        u32x4 o0, o1;
                        o0.x = cvtpk(v00[0], v00[1]); o0.y = cvtpk(v00[2], v00[3]); o0.z = cvtpk(v01[0], v01[1]); o0.w = cvtpk(v01[2], v01[3]);
                        o1.x = cvtpk(v10[0], v10[1]); o1.y = cvtpk(v10[2], v10[3]); o1.z = cvtpk(v11[0], v11[1]); o1.w = cvtpk(v11[2], v11[3]);
                        *(u32x4*)p = o0; *(u32x4*)(p + 32) = o1;
                    }
                }
            } else {
#pragma unroll
                for (int ai = 0; ai < 2; ++ai)
#pragma unroll
                    for (int m = 0; m < 4; ++m) {
                        const int tok = tok0 + ai * 128 + m * 16, b = tok >> 11, s = tok & (SEQ - 1);
                        const f32x4 v00 = acc[ai][0][m][0], v01 = acc[ai][0][m][1], v10 = acc[ai][1][m][0], v11 = acc[ai][1][m][1];
                        const size_t row = (size_t)((b * NGRP + g) * NHEAD + head) * SEQ + (size_t)(s & ((1 << dsh) - 1)) * Lg + (s >> dsh);
                        bf16_t* p = dst + row * HD + 8 * fq;
                        u32x4 o0, o1;
                        o0.x = cvtpk(v00[0], v00[1]); o0.y = cvtpk(v00[2], v00[3]); o0.z = cvtpk(v01[0], v01[1]); o0.w = cvtpk(v01[2], v01[3]);
                        o1.x = cvtpk(v10[0], v10[1]); o1.y = cvtpk(v10[2], v10[3]); o1.z = cvtpk(v11[0], v11[1]); o1.w = cvtpk(v11[2], v11[3]);
                        *(u32x4*)p = o0; *(u32x4*)(p + 32) = o1;
                    }
            }
        } else if (pn < 22) {
            const int ch0 = (pn - 18) * 128 + wc * 32 + 8 * fq;
#pragma unroll
            for (int ai = 0; ai < 2; ++ai)
#pragma unroll
                for (int m = 0; m < 4; ++m) {
                    const int tok = tok0 + ai * 128 + m * 16;
                    const f32x4 a0 = acc[ai][0][m][0], a1 = acc[ai][0][m][1], b0 = acc[ai][1][m][0], b1 = acc[ai][1][m][1];
                    f32x4 r0, r1;
#pragma unroll
                    for (int e = 0; e < 4; ++e) { r0[e] = a0[e] * sigmoidf_(b0[e]); r1[e] = a1[e] * sigmoidf_(b1[e]); }
                    u32x4 o; o.x = cvtpk(r0[0], r0[1]); o.y = cvtpk(r0[2], r0[3]); o.z = cvtpk(r1[0], r1[1]); o.w = cvtpk(r1[2], r1[3]);
                    *(u32x4*)(U + (size_t)tok * CCH + ch0) = o;
                }
        } else {
            const int c0 = (pn - 22) * 256 + wc * 32 + 8 * fq;
#pragma unroll
            for (int bj = 0; bj < 2; ++bj) {
                const f32x4 g0 = *(const f32x4*)(bgate + c0 + bj * 128), g1 = *(const f32x4*)(bgate + c0 + bj * 128 + 4);
#pragma unroll
                for (int ai = 0; ai < 2; ++ai)
#pragma unroll
                    for (int m = 0; m < 4; ++m) {
                        const int tok = tok0 + ai * 128 + m * 16;
                        const f32x4 a0 = acc[ai][bj][m][0] + g0, a1 = acc[ai][bj][m][1] + g1;
                        f32x4 r0, r1;
#pragma unroll
                        for (int e = 0; e < 4; ++e) { r0[e] = sigmoidf_(a0[e]); r1[e] = sigmoidf_(a1[e]); }
                        u32x4 o; o.x = cvtpk(r0[0], r0[1]); o.y = cvtpk(r0[2], r0[3]); o.z = cvtpk(r1[0], r1[1]); o.w = cvtpk(r1[2], r1[3]);
                        *(u32x4*)(G + (size_t)tok * 2048 + c0 + bj * 128) = o;
                    }
            }
        }
        return false;
    }
};

struct EpiMix {
    const bf16_t* G; bf16_t* Z;
    __device__ __forceinline__ bool operator()(AccT& acc, const pg8::Unit& u, int wr, int wc, int fr, int fq) const {
        const int tok0 = u.pm * 256 + wr * 64 + fr, c0 = u.pn * 256 + wc * 32 + 8 * fq;
        if (u.kind == 0) {
#pragma unroll
            for (int am = 0; am < 4; ++am) { const int ai = am >> 1;
                u32x4 ga[4][2], gb[4][2];
#pragma unroll
                for (int m = 2 * (am & 1); m < 2 * (am & 1) + 2; ++m)
#pragma unroll
                    for (int bj = 0; bj < 2; ++bj) { const bf16_t* gp = G + (size_t)(tok0 + ai * 128 + m * 16) * 2048 + c0 + bj * 128; ga[m][bj] = *(const u32x4*)gp; gb[m][bj] = *(const u32x4*)(gp + 1024); }
#pragma unroll
                for (int m = 2 * (am & 1); m < 2 * (am & 1) + 2; ++m)
#pragma unroll
                    for (int bj = 0; bj < 2; ++bj) {
                        const u32x4 wb = gb[m][bj], wa = ga[m][bj];
                        f32x4 b0 = {bf_lo(wb.x), bf_hi(wb.x), bf_lo(wb.y), bf_hi(wb.y)}, b1 = {bf_lo(wb.z), bf_hi(wb.z), bf_lo(wb.w), bf_hi(wb.w)};
                        const f32x4 a0 = {bf_lo(wa.x), bf_hi(wa.x), bf_lo(wa.y), bf_hi(wa.y)}, a1 = {bf_lo(wa.z), bf_hi(wa.z), bf_lo(wa.w), bf_hi(wa.w)};
#pragma unroll
                        for (int e = 0; e < 4; ++e) { b0[e] = fmaxf(b0[e], 1e-30f); b1[e] = fmaxf(b1[e], 1e-30f);
                            acc[ai][bj][m][0][e] *= a0[e] * __builtin_amdgcn_rcpf(b0[e]); acc[ai][bj][m][1][e] *= a1[e] * __builtin_amdgcn_rcpf(b1[e]); }
                    }
            }
        } else {
#pragma unroll
            for (int ai = 0; ai < 2; ++ai) {
                u32x4 gb[4][2];
#pragma unroll
                for (int m = 0; m < 4; ++m)
#pragma unroll
                    for (int bj = 0; bj < 2; ++bj) gb[m][bj] = *(const u32x4*)(G + (size_t)(tok0 + ai * 128 + m * 16) * 2048 + 1024 + c0 + bj * 128);
#pragma unroll
                for (int m = 0; m < 4; ++m)
#pragma unroll
                    for (int bj = 0; bj < 2; ++bj) {
                        const u32x4 wb = gb[m][bj];
                        f32x4 b0 = {bf_lo(wb.x), bf_hi(wb.x), bf_lo(wb.y), bf_hi(wb.y)}, b1 = {bf_lo(wb.z), bf_hi(wb.z), bf_lo(wb.w), bf_hi(wb.w)};
#pragma unroll
                        for (int e = 0; e < 4; ++e) { b0[e] = fmaxf(b0[e], 1e-30f); b1[e] = fmaxf(b1[e], 1e-30f); }
                        const f32x4 r0 = acc[ai][bj][m][0] * b0, r1 = acc[ai][bj][m][1] * b1;
                        u32x4 o; o.x = cvtpk(r0[0], r0[1]); o.y = cvtpk(r0[2], r0[3]); o.z = cvtpk(r1[0], r1[1]); o.w = cvtpk(r1[2], r1[3]);
                        *(u32x4*)(Z + (size_t)(tok0 + ai * 128 + m * 16) * DM + c0 + bj * 128) = o;
                    }
            }
        }
        return u.kind == 0;
    }
};

struct EpiOut {
    const float* X; bf16_t* X1B; float* SSQ;
    __device__ __forceinline__ bool operator()(AccT& acc, const pg8::Unit& u, int wr, int wc, int fr, int fq) const {
        const int tok0 = u.pm * 256 + wr * 64 + fr, c0 = u.pn * 256 + wc * 32 + 8 * fq;
#pragma unroll
        for (int am = 0; am < 4; ++am) { const int ai = am >> 1;
            f32x4 xv[4][2][2];
#pragma unroll
            for (int m = 2 * (am & 1); m < 2 * (am & 1) + 2; ++m)
#pragma unroll
                for (int bj = 0; bj < 2; ++bj) { const float* xp = X + (size_t)(tok0 + ai * 128 + m * 16) * DM + c0 + bj * 128; xv[m][bj][0] = *(const f32x4*)xp; xv[m][bj][1] = *(const f32x4*)(xp + 4); }
#pragma unroll
            for (int m = 2 * (am & 1); m < 2 * (am & 1) + 2; ++m) {
                const int tok = tok0 + ai * 128 + m * 16; float ss = 0.f;
#pragma unroll
                for (int bj = 0; bj < 2; ++bj) {
                    const size_t off = (size_t)tok * DM + c0 + bj * 128;
                    const f32x4 r0 = acc[ai][bj][m][0] + xv[m][bj][0], r1 = acc[ai][bj][m][1] + xv[m][bj][1];
                    u32x4 o; o.x = cvtpk(r0[0], r0[1]); o.y = cvtpk(r0[2], r0[3]); o.z = cvtpk(r1[0], r1[1]); o.w = cvtpk(r1[2], r1[3]);
                    *(u32x4*)(X1B + off) = o;
#pragma unroll
                    for (int e = 0; e < 4; ++e) ss += r0[e] * r0[e] + r1[e] * r1[e];
                }
                ss += __shfl_xor(ss, 16); ss += __shfl_xor(ss, 32);
                if (fq == 0) SSQ[(size_t)(u.pn * 4 + wc) * MTOK + tok] = ss;
            }
        }
        return false;
    }
};

struct EpiFfn1 {
    const float* SSQ; bf16_t* ACT;
    __device__ __forceinline__ bool operator()(AccT& acc, const pg8::Unit& u, int wr, int wc, int fr, int fq) const {
        const int tok0 = u.pm * 256 + wr * 64 + fr, c0 = u.pn * 128 + wc * 32 + 8 * fq;
        float rs[2][4];
#pragma unroll
        for (int ai = 0; ai < 2; ++ai)
#pragma unroll
            for (int m = 0; m < 4; ++m) { const int tok = tok0 + ai * 128 + m * 16; float ss = 0.f;
#pragma unroll
                for (int j = 0; j < 4; ++j) ss += SSQ[(size_t)(4 * fq + j) * MTOK + tok];
                rs[ai][m] = ss; }
#pragma unroll
        for (int ai = 0; ai < 2; ++ai)
#pragma unroll
            for (int m = 0; m < 4; ++m) { float ss = rs[ai][m]; ss += __shfl_xor(ss, 16); ss += __shfl_xor(ss, 32); rs[ai][m] = __builtin_amdgcn_rsqf(ss * (1.0f / DM) + EPS); }
#pragma unroll
        for (int ai = 0; ai < 2; ++ai)
#pragma unroll
            for (int m = 0; m < 4; ++m) {
                const int tok = tok0 + ai * 128 + m * 16;
                const float rstd = rs[ai][m];
                const f32x4 a0 = acc[ai][0][m][0] * rstd, a1 = acc[ai][0][m][1] * rstd, b0 = acc[ai][1][m][0] * rstd, b1 = acc[ai][1][m][1] * rstd;
                f32x4 r0, r1;
#pragma unroll
                for (int e = 0; e < 4; ++e) { r0[e] = a0[e] * sigmoidf_(a0[e]) * b0[e]; r1[e] = a1[e] * sigmoidf_(a1[e]) * b1[e]; }
                u32x4 o; o.x = cvtpk(r0[0], r0[1]); o.y = cvtpk(r0[2], r0[3]); o.z = cvtpk(r1[0], r1[1]); o.w = cvtpk(r1[2], r1[3]);
                *(u32x4*)(ACT + (size_t)tok * DFF + c0) = o;
            }
        return false;
    }
};

struct EpiFfn2 {
    const bf16_t* X1B; float* OUT;
    __device__ __forceinline__ bool operator()(AccT& acc, const pg8::Unit& u, int wr, int wc, int fr, int fq) const {
        const int tok0 = u.pm * 256 + wr * 64 + fr, c0 = u.pn * 256 + wc * 32 + 8 * fq;
#pragma unroll
        for (int ai = 0; ai < 2; ++ai) {
            u32x4 xw[4][2];
#pragma unroll
            for (int m = 0; m < 4; ++m)
#pragma unroll
                for (int bj = 0; bj < 2; ++bj) xw[m][bj] = *(const u32x4*)(X1B + (size_t)(tok0 + ai * 128 + m * 16) * DM + c0 + bj * 128);
#pragma unroll
            for (int m = 0; m < 4; ++m) {
                const int tok = tok0 + ai * 128 + m * 16;
#pragma unroll
                for (int bj = 0; bj < 2; ++bj) {
                    const size_t off = (size_t)tok * DM + c0 + bj * 128;
                    const u32x4 w = xw[m][bj];
                    const f32x4 x0 = {bf_lo(w.x), bf_hi(w.x), bf_lo(w.y), bf_hi(w.y)}, x1 = {bf_lo(w.z), bf_hi(w.z), bf_lo(w.w), bf_hi(w.w)};
                    *(f32x4*)(OUT + off) = acc[ai][bj][m][0] + x0; *(f32x4*)(OUT + off + 4) = acc[ai][bj][m][1] + x1;
                }
            }
        }
        return false;
    }
};

struct AttnRing { u32x4 kr[4]; u32x4 vr[4]; };
__device__ __forceinline__ void att_load(AttnRing& R, const bf16_t* K, const bf16_t* V, int voff, int kt, int klo, int khi) {
    if (kt >= klo && kt <= khi) {
        const bf16_t* kp = K + (voff + kt * 32 * HD); const bf16_t* vp = V + (voff + kt * 32 * HD);
#pragma unroll
        for (int i = 0; i < 4; ++i) R.kr[i] = *(const u32x4*)(kp + i * 8 * HD);
#pragma unroll
        for (int i = 0; i < 4; ++i) R.vr[i] = *(const u32x4*)(vp + i * 8 * HD);
    }
}
template <int KT>
__device__ __forceinline__ void att_step(const AttnRing& R, const bf16x8 (&qf)[4], int klo, int khi, LAS unsigned char* vst, int vwr, int trb0, int trb1,
                                         LAS unsigned char* kst, int kw0, int kw1, int krd, int kf_, int r32, int hi, f32x16 (&o)[2], float& lsum) {
    if (KT >= klo && KT <= khi) {
#pragma unroll
        for (int i = 0; i < 4; ++i) *(LAS u32x4*)(kst + ((i & 1) ? kw1 : kw0) + i * 1024) = R.kr[i];
#pragma unroll
        for (int i = 0; i < 4; ++i) *(LAS u32x4*)(vst + vwr + i * 1024) = R.vr[i];
        bf16x8 kf[4];
#pragma unroll
        for (int s = 0; s < 4; ++s) kf[s] = *(const LAS bf16x8*)(kst + krd + (((2 * s + hi) ^ kf_) << 4));
        f32x16 p = {0.f, 0.f, 0.f, 0.f, 0.f, 0.f, 0.f, 0.f, 0.f, 0.f, 0.f, 0.f, 0.f, 0.f, 0.f, 0.f};
#pragma unroll
        for (int s = 0; s < 4; ++s) p = __builtin_amdgcn_mfma_f32_32x32x16_bf16(kf[s], qf[s], p, 0, 0, 0);
#pragma unroll
        for (int r = 0; r < 16; ++r) { const int kk = (r & 3) + 8 * (r >> 2) + 4 * hi; float e = __builtin_amdgcn_exp2f(p[r]);
            if (KT == 0) e = (kk >= r32) ? e : 0.f;
            if (KT == 4) e = (kk <= r32) ? e : 0.f;
            p[r] = e; }
        lsum += ((p[0] + p[1]) + (p[2] + p[3])) + ((p[4] + p[5]) + (p[6] + p[7])) + (((p[8] + p[9]) + (p[10] + p[11])) + ((p[12] + p[13]) + (p[14] + p[15])));
        bf16x8 pb[2];
#pragma unroll
        for (int s = 0; s < 2; ++s) { u32x4 w; w.x = cvtpk(p[8 * s], p[8 * s + 1]); w.y = cvtpk(p[8 * s + 2], p[8 * s + 3]); w.z = cvtpk(p[8 * s + 4], p[8 * s + 5]); w.w = cvtpk(p[8 * s + 6], p[8 * s + 7]); pb[s] = __builtin_bit_cast(bf16x8, w); }
#pragma unroll
        for (int dt = 0; dt < 2; ++dt)
#pragma unroll
            for (int s = 0; s < 2; ++s) {
                const int tb = dt ? trb1 : trb0;
                const s16x4 lo = __builtin_bit_cast(s16x4, __builtin_amdgcn_ds_read_tr16_b64_v4i16((LAS s16x4*)(vst + tb + s * 2048)));
                const s16x4 hh = __builtin_bit_cast(s16x4, __builtin_amdgcn_ds_read_tr16_b64_v4i16((LAS s16x4*)(vst + tb + s * 2048 + 1024)));
                const bf16x8 vf = {lo[0], lo[1], lo[2], lo[3], hh[0], hh[1], hh[2], hh[3]};
                o[dt] = __builtin_amdgcn_mfma_f32_32x32x16_bf16(vf, pb[s], o[dt], 0, 0, 0);
            }
        LDS_WAIT();
    }
}
__device__ __forceinline__ int acc_row(int t) { return (t & 0xF0) | ((t + (t >> 4)) & 15); }
__device__ __forceinline__ void attn_merge(LAS float* accO, LAS float* accL, const f32x16 (&o)[2], float l, int tk, int hi, bool first) {
    if (tk >= 0) {
        const int row = acc_row(tk);
#pragma unroll
        for (int dt = 0; dt < 2; ++dt)
#pragma unroll
            for (int rg = 0; rg < 4; ++rg) {
                LAS f32x4* p = (LAS f32x4*)(accO + row * 68 + 32 * dt + 8 * rg + 4 * hi);
                f32x4 v = {o[dt][4 * rg], o[dt][4 * rg + 1], o[dt][4 * rg + 2], o[dt][4 * rg + 3]};
                if (!first) v = v + *p;
                *p = v;
            }
        if (hi == 0) { if (!first) l += accL[tk]; accL[tk] = l; }
    }
}
__device__ __forceinline__ void attn_finalize(const LAS float* accO, const LAS float* accL, bf16_t* AU, int b, int h, int chunk, int tid) {
    const int tk = tid >> 1, half = tid & 1;
    const float rl = 1.0f / accL[tk];
    const LAS f32x4* p = (const LAS f32x4*)(accO + acc_row(tk) * 68 + 32 * half);
    bf16_t* dst = AU + (size_t)(b * SEQ + 256 * chunk + tk) * DM + h * HD + 32 * half;
#pragma unroll
    for (int i = 0; i < 4; ++i) { const f32x4 a = p[2 * i] * rl, bb = p[2 * i + 1] * rl;
        u32x4 ov; ov.x = cvtpk(a[0], a[1]); ov.y = cvtpk(a[2], a[3]); ov.z = cvtpk(bb[0], bb[1]); ov.w = cvtpk(bb[2], bb[3]);
        *(u32x4*)(dst + 8 * i) = ov; }
}
struct AttnTile { size_t seq0; int Lg, q0; };
__device__ __forceinline__ AttnTile attn_desc(int j, int b, int h, int sc, int w) {
    AttnTile t;
    if (j < 2) { t.seq0 = (size_t)((b * NGRP + 2) * NHEAD + h) * SEQ + (size_t)(2 * w + j) * 128; t.Lg = 128; t.q0 = 32 * sc; }
    else { const int c = 2 * sc + ((j - 2) >> 1);
        if ((j & 1) == 0) { t.seq0 = (size_t)((b * NGRP + 0) * NHEAD + h) * SEQ; t.Lg = 2048; t.q0 = 256 * c + 32 * w; }
        else { t.seq0 = (size_t)((b * NGRP + 1) * NHEAD + h) * SEQ + (size_t)(w >> 1) * 512; t.Lg = 512; t.q0 = 64 * c + 32 * (w & 1); } }
    return t;
}
__device__ __forceinline__ void attn_super(const bf16_t* Q, const bf16_t* K, const bf16_t* V, bf16_t* AU, float negc, LAS unsigned char* scr, int item) {
    int tid = threadIdx.x; asm volatile("" : "+v"(tid));
    const int lane = tid & 63, w = __builtin_amdgcn_readfirstlane(tid >> 6), r32 = lane & 31, hi = lane >> 5;
    const int sc = item & 3, h = (item >> 2) & 7, b = item >> 5;
    LAS float* accO = (LAS float*)scr;
    LAS float* accL = (LAS float*)(scr + 256 * 68 * 4);
    LAS unsigned char* vst = scr + 256 * 68 * 4 + 1024 + w * 4096;
    const int vwr = (lane >> 3) * 128 + (((lane & 7) * 16) ^ (((lane >> 4) & 1) << 6));
    const int qsw = ((lane & 15) >> 3) & 1;
    const int trrow = (4 * hi + ((lane & 15) >> 2)) * 128 + ((lane >> 4) & 1) * 32 + (lane & 3) * 8;
    const int trb0 = trrow + 64 * qsw, trb1 = trrow + 64 * (1 - qsw);
    LAS unsigned char* kst = scr + 256 * 68 * 4 + 1024 + 32768 + w * 4096;
    const int kw0 = (lane >> 3) * 128 + (((lane & 7) ^ (lane >> 4)) << 4), kw1 = (lane >> 3) * 128 + (((lane & 7) ^ ((lane >> 4) + 4)) << 4);
    const int krd = r32 * 128, kf_ = (r32 >> 1) & 7;
    AttnRing R0, R1, R2;
    f32x16 og2[2]; float lg2 = 0.f;
    AttnTile cur = attn_desc(0, b, h, sc, w);
    int klo = cur.q0 >= 64 ? 0 : 2 - (cur.q0 >> 5), khi = ((cur.Lg - cur.q0 + 32) >> 5) > 4 ? 4 : ((cur.Lg - cur.q0 + 32) >> 5);
    int voff = ((int)cur.seq0 + cur.q0 - 64 + (lane >> 3)) * HD + (lane & 7) * 8;
    bf16x8 qf[4];
    att_load(R0, K, V, voff, 0, klo, khi); att_load(R1, K, V, voff, 1, klo, khi);
    { const bf16_t* qp = Q + (cur.seq0 + cur.q0 + r32) * HD + 8 * hi;
#pragma unroll
      for (int s = 0; s < 4; ++s) qf[s] = *(const bf16x8*)(qp + 16 * s); }
#pragma unroll 1
    for (int j = 0; j < 6; ++j) {
        f32x16 o[2]; float ls = 0.f;
#pragma unroll
        for (int r = 0; r < 16; ++r) { o[0][r] = 0.f; o[1][r] = 0.f; }
        att_load(R2, K, V, voff, 2, klo, khi);
        att_step<0>(R0, qf, klo, khi, vst, vwr, trb0, trb1, kst, kw0, kw1, krd, kf_, r32, hi, o, ls);
        att_load(R0, K, V, voff, 3, klo, khi);
        att_step<1>(R1, qf, klo, khi, vst, vwr, trb0, trb1, kst, kw0, kw1, krd, kf_, r32, hi, o, ls);
        att_load(R1, K, V, voff, 4, klo, khi);
        att_step<2>(R2, qf, klo, khi, vst, vwr, trb0, trb1, kst, kw0, kw1, krd, kf_, r32, hi, o, ls);
        const AttnTile nxt = attn_desc(j < 5 ? j + 1 : 5, b, h, sc, w);
        const int nklo = nxt.q0 >= 64 ? 0 : 2 - (nxt.q0 >> 5), nkhi = ((nxt.Lg - nxt.q0 + 32) >> 5) > 4 ? 4 : ((nxt.Lg - nxt.q0 + 32) >> 5);
        const int nvoff = ((int)nxt.seq0 + nxt.q0 - 64 + (lane >> 3)) * HD + (lane & 7) * 8;
        att_step<3>(R0, qf, klo, khi, vst, vwr, trb0, trb1, kst, kw0, kw1, krd, kf_, r32, hi, o, ls);
        if (j < 5) att_load(R0, K, V, nvoff, 0, nklo, nkhi);
        att_step<4>(R1, qf, klo, khi, vst, vwr, trb0, trb1, kst, kw0, kw1, krd, kf_, r32, hi, o, ls);
        if (j < 5) { att_load(R1, K, V, nvoff, 1, nklo, nkhi);
            const bf16_t* qp = Q + (nxt.seq0 + nxt.q0 + r32) * HD + 8 * hi;
#pragma unroll
            for (int s = 0; s < 4; ++s) qf[s] = *(const bf16x8*)(qp + 16 * s); }
        const float l = ls + __shfl_xor(ls, 32);
        int tq = threadIdx.x; asm volatile("" : "+v"(tq));
        const int r32m = tq & 31, him = (tq >> 5) & 1;
        if (j < 2) {
            attn_merge(accO, accL, o, l, r32m < 16 ? 16 * r32m + 2 * w + j : -1, him, true);
            if (j == 0) { og2[0] = o[0]; og2[1] = o[1]; lg2 = l; }
            else {
#pragma unroll
                for (int r = 0; r < 16; ++r) { const float m0 = __shfl_xor(o[0][r], 16), m1 = __shfl_xor(o[1][r], 16); if (r32m < 16) { og2[0][r] = m0; og2[1][r] = m1; } }
                const float ml = __shfl_xor(l, 16); if (r32m < 16) lg2 = ml;
            }
        } else if ((j & 1) == 0) {
            __syncthreads();
            attn_merge(accO, accL, o, l, 32 * w + r32m, him, false);
        } else {
            __syncthreads();
            attn_merge(accO, accL, o, l, 4 * (32 * (w & 1) + r32m) + (w >> 1), him, false);
            __syncthreads();
            attn_finalize(accO, accL, AU, b, h, 2 * sc + ((j - 3) >> 1), tq);
            __syncthreads();
            if (j == 3) attn_merge(accO, accL, og2, lg2, r32m >= 16 ? 16 * (r32m - 16) + 2 * w : 16 * r32m + 2 * w + 1, him, true);
        }
        cur = nxt; klo = nklo; khi = nkhi; voff = nvoff;
    }
}

__device__ __forceinline__ void conv_unit(const bf16_t* U, const float* cw, const float* cb, const float* lnw, const float* lnb, bf16_t* AU, LAS unsigned char* scr, int unit) {
    int tid = threadIdx.x; asm volatile("" : "+v"(tid));
    const int lane = tid & 63, w = tid >> 6;
    const int b = unit >> 5, s0 = (unit & 31) * 64;
    const int cp = tid & 255, tg = tid >> 8;
    LAS float* cbuf = (LAS float*)scr;
    unsigned win[62];
#pragma unroll
    for (int i = 0; i < 62; ++i) { const int s = s0 + 32 * tg - 15 + i; win[i] = (s >= 0 && s < SEQ) ? *(const unsigned*)(U + (size_t)(b * SEQ + s) * CCH + 2 * cp) : 0u; }
    f32x2 acc[32];
    const f32x2 bias = *(const f32x2*)(cb + 2 * cp);
#pragma unroll
    for (int k = 0; k < 32; ++k) acc[k] = bias;
#pragma unroll
    for (int j = 0; j < CW; ++j) {
        const f32x2 wj = *(const f32x2*)(cw + j * CCH + 2 * cp);
#pragma unroll
        for (int k = 0; k < 32; ++k) { acc[k].x += wj.x * bf_lo(win[k + j]); acc[k].y += wj.y * bf_hi(win[k + j]); }
    }
#pragma unroll
    for (int k = 0; k < 32; ++k) *(LAS f32x2*)(cbuf + (32 * tg + k) * 516 + 2 * cp) = acc[k];
    __syncthreads();
    const f32x4 g0 = *(const f32x4*)(lnw + 4 * lane), g1 = *(const f32x4*)(lnw + 256 + 4 * lane), e0 = *(const f32x4*)(lnb + 4 * lane), e1 = *(const f32x4*)(lnb + 256 + 4 * lane);
    f32x4 va[8], vc[8]; float sm[8], sq[8];
#pragma unroll
    for (int k = 0; k < 8; ++k) { const int t = 8 * w + k;
        va[k] = *(const LAS f32x4*)(cbuf + t * 516 + 4 * lane); vc[k] = *(const LAS f32x4*)(cbuf + t * 516 + 256 + 4 * lane);
        sm[k] = (va[k][0] + va[k][1]) + (va[k][2] + va[k][3]) + (vc[k][0] + vc[k][1]) + (vc[k][2] + vc[k][3]); }
#pragma unroll
    for (int o = 1; o < 64; o <<= 1)
#pragma unroll
        for (int k = 0; k < 8; ++k) sm[k] += __shfl_xor(sm[k], o);
#pragma unroll
    for (int k = 0; k < 8; ++k) { const float mean = sm[k] * (1.0f / CCH); va[k] = va[k] - mean; vc[k] = vc[k] - mean;
        sq[k] = (va[k][0] * va[k][0] + va[k][1] * va[k][1]) + (va[k][2] * va[k][2] + va[k][3] * va[k][3]) + (vc[k][0] * vc[k][0] + vc[k][1] * vc[k][1]) + (vc[k][2] * vc[k][2] + vc[k][3] * vc[k][3]); }
#pragma unroll
    for (int o = 1; o < 64; o <<= 1)
#pragma unroll
        for (int k = 0; k < 8; ++k) sq[k] += __shfl_xor(sq[k], o);
#pragma unroll
    for (int k = 0; k < 8; ++k) {
        const int t = 8 * w + k;
        const float rstd = __builtin_amdgcn_rsqf(sq[k] * (1.0f / CCH) + EPS);
        f32x4 a = va[k] * rstd * g0 + e0, c = vc[k] * rstd * g1 + e1;
#pragma unroll
        for (int e = 0; e < 4; ++e) { a[e] = a[e] * sigmoidf_(a[e]); c[e] = c[e] * sigmoidf_(c[e]); }
        bf16_t* dst = AU + (size_t)(b * SEQ + s0 + t) * DM + CCH;
        u32x2 oa, oc; oa.x = cvtpk(a[0], a[1]); oa.y = cvtpk(a[2], a[3]); oc.x = cvtpk(c[0], c[1]); oc.y = cvtpk(c[2], c[3]);
        *(u32x2*)(dst + 4 * lane) = oa; *(u32x2*)(dst + 256 + 4 * lane) = oc;
    }
    __syncthreads();
}

__device__ __forceinline__ void p0_load(const float* W, int N, int k0, int cbase, const float* kscale, f32x4 (&v)[8], int lane) {
#pragma unroll
    for (int i = 0; i < 8; ++i) { const int kk = 8 * i + (lane >> 3); v[i] = *(const f32x4*)(W + (size_t)(k0 + kk) * N + cbase + 4 * (lane & 7)); if (kscale) v[i] = v[i] * kscale[k0 + kk]; }
}
__device__ __forceinline__ void p0_store(const f32x4 (&v)[8], int k0, bool qkperm, bf16_t* WT, int ldo, int kdst, int rho0, LAS float* scr, int lane) {
#pragma unroll
    for (int i = 0; i < 8; ++i) { LAS float* d = scr + (8 * i + (lane >> 3)) * 33 + 4 * (lane & 7); d[0] = v[i][0]; d[1] = v[i][1]; d[2] = v[i][2]; d[3] = v[i][3]; }
    LDS_WAIT(); asm volatile("" ::: "memory");
    const int c = lane & 7;
#pragma unroll
    for (int j = 0; j < 4; ++j) {
        const int n = (lane >> 3) + 8 * j;
        int src = perm32(n); if (qkperm) src = pos2dim(src);
        const LAS float* sp = scr + (8 * c) * 33 + src;
        u32x4 o; o.x = cvtpk(sp[0 * 33], sp[1 * 33]); o.y = cvtpk(sp[2 * 33], sp[3 * 33]); o.z = cvtpk(sp[4 * 33], sp[5 * 33]); o.w = cvtpk(sp[6 * 33], sp[7 * 33]);
        *(u32x4*)(WT + (size_t)(rho0 + n) * ldo + kdst + k0 + 8 * c) = o;
    }
    LDS_WAIT(); asm volatile("" ::: "memory");
}

struct Params {
    const float* x; const int* pos; const float *norm1_w, *w_in, *b_gate, *q_norm_w, *k_norm_w, *w_o_attn, *conv_w, *conv_b, *conv_ln_w, *conv_ln_b, *w_pw_conv, *w_out, *norm2_w, *w_ffn_in, *w_ffn_out;
    float* out; unsigned char* ws;
};

__constant__ double c_invfreq[8] = {1.0, 0.19392274474868576, 0.03760603093086393, 0.007292664737217109, 0.001414213562373095, 0.0002742481756762073, 5.318295896944988e-05, 1.031338537721246e-05};

constexpr int I_IN = 16 * (NIN / 32), I_O = 8 * 32, I_PW = 8 * 32, I_OUT = 16 * 32, I_F1 = 16 * (NF1 / 32), I_F2 = (DFF / 64) * 32;
constexpr int P0_NITEMS = I_IN + I_O + I_PW + I_OUT + I_F1 + I_F2;
template <bool LOAD>
__device__ __forceinline__ void p0_item(const Params& P, int it, f32x4 (&v)[8], LAS float* scr, int lane) {
    unsigned char* ws = P.ws;
    int r = it;
    if (r < I_IN) {
        const int kb = r / (NIN / 32), gi = r % (NIN / 32), rho0 = gi * 32;
        const int pn = rho0 >> 8, bj = (rho0 >> 7) & 1, wc = (rho0 >> 5) & 3;
        int cbase; bool qk = false;
        if (pn < 18) { const int sec = pn / 6, pt = pn - sec * 6, g = pt >> 1, head = 4 * (pt & 1) + wc; cbase = sec * QKVW + g * 512 + head * 64 + 32 * bj; qk = (sec < 2) && (bj == 0); }
        else if (pn < 22) cbase = 3 * QKVW + 512 * bj + (pn - 18) * 128 + 32 * wc;
        else cbase = 3 * QKVW + 1024 + (pn - 22) * 256 + 128 * bj + 32 * wc;
        if (LOAD) p0_load(P.w_in, NIN, kb * 64, cbase, nullptr, v, lane); else p0_store(v, kb * 64, qk, (bf16_t*)(ws + WS_WIN), DM, 0, rho0, scr, lane);
        return; }
    r -= I_IN;
    if (r < I_O) { const int kb = r / 32, gi = r % 32; if (LOAD) p0_load(P.w_o_attn, DM, kb * 64, gi * 32, nullptr, v, lane); else p0_store(v, kb * 64, false, (bf16_t*)(ws + WS_WCAT), DM, 0, gi * 32, scr, lane); return; }
    r -= I_O;
    if (r < I_PW) { const int kb = r / 32, gi = r % 32; if (LOAD) p0_load(P.w_pw_conv, DM, kb * 64, gi * 32, nullptr, v, lane); else p0_store(v, kb * 64, false, (bf16_t*)(ws + WS_WCAT), DM, 512, gi * 32, scr, lane); return; }
    r -= I_PW;
    if (r < I_OUT) { const int kb = r / 32, gi = r % 32; if (LOAD) p0_load(P.w_out, DM, kb * 64, gi * 32, nullptr, v, lane); else p0_store(v, kb * 64, false, (bf16_t*)(ws + WS_WOUT), DM, 0, gi * 32, scr, lane); return; }
    r -= I_OUT;
    if (r < I_F1) {
        const int kb = r / (NF1 / 32), gi = r % (NF1 / 32), rho0 = gi * 32;
        const int pn = rho0 >> 8, bj = (rho0 >> 7) & 1, wc = (rho0 >> 5) & 3;
        if (LOAD) p0_load(P.w_ffn_in, NF1, kb * 64, DFF * bj + 128 * pn + 32 * wc, P.norm2_w, v, lane); else p0_store(v, kb * 64, false, (bf16_t*)(ws + WS_WF1), DM, 0, rho0, scr, lane);
        return; }
    r -= I_F1;
    { const int kb = r / 32, gi = r % 32; if (LOAD) p0_load(P.w_ffn_out, DM, kb * 64, gi * 32, nullptr, v, lane); else p0_store(v, kb * 64, false, (bf16_t*)(ws + WS_WF2), DFF, 0, gi * 32, scr, lane); }
}

__device__ __forceinline__ void p0_weights(const Params& P, LAS float* scr, int lane, int iw, int nw, int lo, int hi) {
    f32x4 va[8], vb[8];
    int it = lo + iw;
    if (it < hi) p0_item<true>(P, it, va, scr, lane);
    while (it < hi) {
        const int nx = it + nw;
        if (nx < hi) p0_item<true>(P, nx, vb, scr, lane);
        p0_item<false>(P, it, va, scr, lane);
        it = nx;
        if (it >= hi) break;
        const int nx2 = it + nw;
        if (nx2 < hi) p0_item<true>(P, nx2, va, scr, lane);
        p0_item<false>(P, it, vb, scr, lane);
        it = nx2;
    }
}
__device__ __forceinline__ void p0_prologue(const Params& P, LAS unsigned char* scrb, int vcu, int G) {
    int tid = threadIdx.x; asm volatile("" : "+v"(tid));
    const int lane = tid & 63, wave = tid >> 6;
    LAS float* scr = (LAS float*)(scrb + wave * 16384);
    const int gw = vcu * 8 + wave, NGW = G * 8;
    unsigned char* ws = P.ws;
    bf16_t* Hn = (bf16_t*)((unsigned char*)P.out + DO_H);
    { f32x4 nw[4];
#pragma unroll
      for (int j = 0; j < 4; ++j) nw[j] = *((const f32x4*)P.norm1_w + lane + 64 * j);
      for (int m0 = gw; m0 < MTOK; m0 += 4 * NGW) {
        f32x4 v[4][4];
#pragma unroll
        for (int q = 0; q < 4; ++q) { const int m = m0 + q * NGW; if (m < MTOK) { const f32x4* xr = (const f32x4*)(P.x + (size_t)m * DM) + lane;
#pragma unroll
            for (int j = 0; j < 4; ++j) v[q][j] = xr[64 * j]; } }
#pragma unroll
        for (int q = 0; q < 4; ++q) { const int m = m0 + q * NGW; if (m < MTOK) {
            float s = 0.f;
#pragma unroll
            for (int j = 0; j < 4; ++j) s += (v[q][j][0] * v[q][j][0] + v[q][j][1] * v[q][j][1]) + (v[q][j][2] * v[q][j][2] + v[q][j][3] * v[q][j][3]);
            const float rstd = __builtin_amdgcn_rsqf(wave_sum(s) * (1.0f / DM) + EPS);
            u32x2* o8 = (u32x2*)(Hn + (size_t)m * DM) + lane;
#pragma unroll
            for (int j = 0; j < 4; ++j) { const f32x4 y = v[q][j] * rstd * nw[j]; u32x2 o; o.x = cvtpk(y[0], y[1]); o.y = cvtpk(y[2], y[3]); o8[64 * j] = o; } } }
      } }
    p0_weights(P, scr, lane, gw, NGW, 0, I_IN);
    float* rope = (float*)(ws + WS_ROPE);
    for (int i = vcu * 512 + tid; i < MTOK * 8; i += G * 512) {
        const int tok = i >> 3, f = i & 7;
        const double ang = (double)P.pos[tok] * c_invfreq[f];
        const double kq = __builtin_rint(ang * 0.15915494309189535);
        const double xr = __builtin_fma(-kq, 6.283185307179586, ang) - kq * 2.4492935982947064e-16;
        const double x2 = xr * xr;
        double sn = 1.0, cs = 1.0;
#pragma unroll
        for (int n = 12; n >= 1; --n) { sn = 1.0 - sn * x2 / (double)((2 * n) * (2 * n + 1)); cs = 1.0 - cs * x2 / (double)((2 * n - 1) * (2 * n)); }
        sn *= xr;
        rope[(size_t)tok * 16 + f] = (float)cs; rope[(size_t)tok * 16 + 8 + f] = (float)sn;
    }
}

#define RLX_AGENT __ATOMIC_RELAXED, __HIP_MEMORY_SCOPE_AGENT
#define XB_TMO      128
#define XB_XCNT(j)  (256  + 64 * (j))
#define XB_XSUB(j)  (1280 + 64 * (j))
#define XB_XGEN(j)  (2304 + 64 * (j))
#define XB_TOP      3328
#define XB_TOPGEN   3392
#define XCD_BAR_WORDS 3456
#define XB_SPIN_CAP (1u << 18)
__device__ __forceinline__ unsigned xb_ld(unsigned* p)              { return __hip_atomic_load(p, __ATOMIC_RELAXED, __HIP_MEMORY_SCOPE_AGENT); }
__device__ __forceinline__ unsigned xb_add(unsigned* p, unsigned v) { return __hip_atomic_fetch_add(p, v, __ATOMIC_RELAXED, __HIP_MEMORY_SCOPE_AGENT); }
__device__ __forceinline__ unsigned xb_xcc_id() { return (unsigned)__builtin_amdgcn_s_getreg((3 << 11) | 20) & 0xFu; }
#define XB_SPIN(cond, bar) do { unsigned _sp = 0; while (cond) { __builtin_amdgcn_s_sleep(1); \
    if ((++_sp & 255u) == 0u) { if (xb_ld(&(bar)[XB_TMO])) break; if (_sp > XB_SPIN_CAP) { atomicAdd(&(bar)[XB_TMO], 1u); break; } } } } while (0)
struct XcdBarrier { unsigned* bar; unsigned x; volatile LAS unsigned* st; };
__device__ __forceinline__ XcdBarrier xcd_barrier_post(unsigned* bar, volatile LAS unsigned* st) {
    XcdBarrier b; b.bar = bar; b.x = xb_xcc_id(); b.st = st;
    if (threadIdx.x == 0) (void)xb_add(&bar[XB_XCNT(b.x)], 1u);
    return b;
}
__device__ __forceinline__ void xcd_barrier_complete(unsigned* bar, unsigned x, unsigned& nloc, unsigned& nx) {
    const unsigned G = gridDim.x * gridDim.y * gridDim.z;
    unsigned sum, cnt, mine, sp = 0u;
    for (;;) {
        sum = 0u; cnt = 0u; mine = 0u;
#pragma unroll
        for (unsigned j = 0; j < 16; ++j) { const unsigned c = xb_ld(&bar[XB_XCNT(j)]); sum += c; cnt += (c > 0u) ? 1u : 0u; mine = (j == x) ? c : mine; }
        if (sum == G) break;
        __builtin_amdgcn_s_sleep(1);
        if ((++sp & 255u) == 0u) { if (xb_ld(&bar[XB_TMO])) break; if (sp > XB_SPIN_CAP) { atomicAdd(&bar[XB_TMO], 1u); break; } }
    }
    nloc = mine > 0u ? mine : 1u; nx = cnt > 0u ? cnt : 1u;
}
__device__ __forceinline__ void xcd_barrier(const XcdBarrier& b) {
    asm volatile("s_waitcnt vmcnt(0)" ::: "memory");
    __syncthreads();
    if (threadIdx.x == 0) {
        unsigned* bar = b.bar;
        __builtin_amdgcn_s_waitcnt(0);
        unsigned nloc = b.st[0], nx = b.st[1];
        if (nloc == 0u) { xcd_barrier_complete(bar, b.x, nloc, nx); b.st[0] = nloc; b.st[1] = nx; }
        const unsigned old = xb_add(&bar[XB_XSUB(b.x)], 1u);
        const unsigned gen = old / nloc;
        if (old + 1u == (gen + 1u) * nloc) {
            __builtin_amdgcn_fence(__ATOMIC_RELEASE, "agent");
            asm volatile("s_waitcnt vmcnt(0)" ::: "memory");
            const unsigned og = xb_add(&bar[XB_TOP], 1u);
            const unsigned tg = og / nx;
            if (og + 1u == (tg + 1u) * nx) xb_add(&bar[XB_TOPGEN], 1u);
            else XB_SPIN(xb_ld(&bar[XB_TOPGEN]) == tg, bar);
            __builtin_amdgcn_fence(__ATOMIC_ACQUIRE, "agent");
            xb_add(&bar[XB_XGEN(b.x)], 1u);
            asm volatile("s_waitcnt vmcnt(0)" ::: "memory");
        } else {
            XB_SPIN(xb_ld(&bar[XB_XGEN(b.x)]) == gen, bar);
            __builtin_amdgcn_fence(__ATOMIC_ACQUIRE, "agent");
            asm volatile("s_waitcnt vmcnt(0)" ::: "memory");
        }
    }
    __syncthreads();
}

#ifndef REP_P0
#define REP_P0 1
#endif
#ifndef REP_P1
#define REP_P1 1
#endif
#ifndef REP_P2A
#define REP_P2A 1
#endif
#ifndef REP_P2C
#define REP_P2C 1
#endif
#ifndef REP_P3A
#define REP_P3A 1
#endif
#ifndef REP_P3B
#define REP_P3B 1
#endif
#ifndef REP_P3C
#define REP_P3C 1
#endif
#ifndef REP_P3D
#define REP_P3D 1
#endif
#ifndef PROBE_SPIN
#define PROBE_SPIN 0
#endif
#ifndef EXTRA_SYNC
#define EXTRA_SYNC 0
#endif
__global__ void __launch_bounds__(512, 2) fwd_kernel(Params P) {
    extern __shared__ __attribute__((aligned(16))) unsigned char lds_raw[];
    LAS unsigned char* lds = (LAS unsigned char*)lds_raw;
    LAS unsigned char* scr = lds + LDS_SCR;
    const int G = gridDim.x, bx = blockIdx.x;
    const int vcu = (G % 8 == 0) ? (bx % 8) * (G / 8) + bx / 8 : bx;
    unsigned char* ws = P.ws; unsigned char* ob = (unsigned char*)P.out;
    bf16_t* Qb = (bf16_t*)(ws + WS_Q); bf16_t* Kb = (bf16_t*)(ws + WS_K); bf16_t* Vb = (bf16_t*)(ws + WS_V); bf16_t* Gt = (bf16_t*)(ws + WS_GATE);
    bf16_t* Ub = (bf16_t*)(ob + DO_U); bf16_t* AU = (bf16_t*)(ob + DO_AU); bf16_t* Hn = (bf16_t*)(ob + DO_H);
    float* SSQ = (float*)(ws + WS_SSQ);

    if (threadIdx.x < 64) ((LAS unsigned*)(lds + LDS_MISC))[threadIdx.x] = 0u;
    __syncthreads();
    const XcdBarrier xbar = xcd_barrier_post((unsigned*)(ws + WS_CTL) + 4096, (volatile LAS unsigned*)(lds + LDS_MISC) + 8);
    unsigned long long tprev = PROBE_SPIN ? __builtin_amdgcn_s_memrealtime() : 0ull;
#define SEAM(k, dosync) do { if (dosync) xcd_barrier(xbar); if (PROBE_SPIN) { const unsigned long long now_ = __builtin_amdgcn_s_memrealtime(); \
        if (PROBE_SPIN == (k)) { const unsigned long long d_ = now_ - tprev; while (__builtin_amdgcn_s_memrealtime() - now_ < d_) __builtin_amdgcn_s_sleep(8); } \
        tprev = __builtin_amdgcn_s_memrealtime(); } } while (0)
    for (int rep = 0; rep < REP_P0; ++rep) p0_prologue(P, scr, vcu, G);
    for (int rep = 0; rep < EXTRA_SYNC; ++rep) xcd_barrier(xbar);
    SEAM(1, 1);

    { pg8::Gemm g{Hn, (const bf16_t*)(ws + WS_WIN), DM, DM, DM, 0}; pg8::StaticOrder S; S.init(MTOK, NIN, G, bx);
      EpiIn E{Qb, Kb, Vb, Ub, Gt, P.q_norm_w, P.k_norm_w, P.b_gate, (const float*)(ws + WS_ROPE)};
      for (int rep = 0; rep < REP_P1; ++rep) pg8::gemm_phase(scr, g, S, E);
      const int nun = (MTOK / 256) * (NIN / 256), rem = nun % G, nidle = rem ? G - rem : G, iw = rem ? bx - rem : bx;
      if (iw >= 0) { int tid = threadIdx.x; asm volatile("" : "+v"(tid));
          p0_weights(P, (LAS float*)(scr + (tid >> 6) * 16384), tid & 63, iw * 8 + (tid >> 6), nidle * 8, I_IN, P0_NITEMS); } }
    SEAM(2, 1);

    { float qm = 0.f, km = 0.f;
      for (int i = 0; i < HD; ++i) { qm = fmaxf(qm, fabsf(P.q_norm_w[i])); km = fmaxf(km, fabsf(P.k_norm_w[i])); }
      const float negc = -fminf(8.0f * qm * km * LOG2E, 60.0f);
      for (int rep = 0; rep < REP_P2A; ++rep) for (int it = vcu; it < BATCH * NHEAD * 4; it += G) attn_super(Qb, Kb, Vb, AU, negc, scr, it);
      for (int rep = 0; rep < REP_P2C; ++rep) for (int un = vcu; un < BATCH * 32; un += G) conv_unit(Ub, P.conv_w, P.conv_b, P.conv_ln_w, P.conv_ln_b, AU, scr, un); }
    SEAM(3, 1);

    { pg8::Gemm g{AU, (const bf16_t*)(ws + WS_WCAT), DM, DM, 512, 512}; pg8::StaticOrder S; S.init(MTOK, DM, G, bx, 2);
      EpiMix E{Gt, (bf16_t*)(ws + WS_Z)};
      for (int rep = 0; rep < REP_P3A; ++rep) pg8::gemm_phase(scr, g, S, E); }
    SEAM(4, 1);

    { pg8::Gemm g{(const bf16_t*)(ws + WS_Z), (const bf16_t*)(ws + WS_WOUT), DM, DM, DM, 0}; pg8::StaticOrder S; S.init(MTOK, DM, G, bx);
      EpiOut E{P.x, (bf16_t*)(ws + WS_X1B), SSQ};
      for (int rep = 0; rep < REP_P3B; ++rep) pg8::gemm_phase(scr, g, S, E); }
    SEAM(5, 1);

    { pg8::Gemm g{(const bf16_t*)(ws + WS_X1B), (const bf16_t*)(ws + WS_WF1), DM, DM, DM, 0}; pg8::StaticOrder S; S.init(MTOK, NF1, G, bx);
      EpiFfn1 E{SSQ, (bf16_t*)(ws + WS_ACT)};
      for (int rep = 0; rep < REP_P3C; ++rep) pg8::gemm_phase(scr, g, S, E); }
    SEAM(6, 1);

    { pg8::Gemm g{(const bf16_t*)(ws + WS_ACT), (const bf16_t*)(ws + WS_WF2), DFF, DFF, DFF, 0}; pg8::StaticOrder S; S.init(MTOK, DM, G, bx);
      for (int rep = 1; rep < REP_P3D; ++rep) { EpiFfn2 E0{(const bf16_t*)(ws + WS_X1B), (float*)(ws + WS_GATE)}; pg8::gemm_phase(scr, g, S, E0); }
      EpiFfn2 E{(const bf16_t*)(ws + WS_X1B), P.out};
      pg8::gemm_phase(scr, g, S, E); }
    SEAM(7, 0);
}

extern "C" void kernel_launch(void* const* d_in, const int* in_sizes, int n_in, void* d_out, int out_size, void* d_ws, size_t ws_size, hipStream_t stream) {
    static int grid = 0;
    if (grid == 0) {
        if (n_in != 17 || out_size != MTOK * DM || ws_size < WS_END) { fprintf(stderr, "kernel_launch: unexpected shapes (n_in %d out %d ws %zu)\n", n_in, out_size, ws_size); grid = -1; return; }
        int dev = 0, cus = 0, per_cu = 0;
        hipGetDevice(&dev);
        hipDeviceGetAttribute(&cus, hipDeviceAttributeMultiprocessorCount, dev);
        hipFuncSetAttribute((const void*)fwd_kernel, hipFuncAttributeMaxDynamicSharedMemorySize, LDS_BYTES);
        hipOccupancyMaxActiveBlocksPerMultiprocessor(&per_cu, (const void*)fwd_kernel, 512, LDS_BYTES);
        if (per_cu < 1) { fprintf(stderr, "kernel_launch: occupancy query says %d blocks per CU\n", per_cu); grid = -1; return; }
        grid = cus * (per_cu < 1 ? 0 : 1);
        fprintf(stderr, "kernel_launch: grid %d (occupancy %d per CU)\n", grid, per_cu);
    }
    if (grid < 0) return;
    Params p{};
    p.x = (const float*)d_in[0]; p.pos = (const int*)d_in[1]; p.norm1_w = (const float*)d_in[2]; p.w_in = (const float*)d_in[3]; p.b_gate = (const float*)d_in[4];
    p.q_norm_w = (const float*)d_in[5]; p.k_norm_w = (const float*)d_in[6]; p.w_o_attn = (const float*)d_in[7]; p.conv_w = (const float*)d_in[8]; p.conv_b = (const float*)d_in[9];
    p.conv_ln_w = (const float*)d_in[10]; p.conv_ln_b = (const float*)d_in[11]; p.w_pw_conv = (const float*)d_in[12]; p.w_out = (const float*)d_in[13]; p.norm2_w = (const float*)d_in[14];
    p.w_ffn_in = (const float*)d_in[15]; p.w_ffn_out = (const float*)d_in[16]; p.out = (float*)d_out; p.ws = (unsigned char*)d_ws;
    if (hipMemsetAsync((char*)d_ws + WS_CTL, 0, CTL_BYTES, stream) != hipSuccess) { fprintf(stderr, "kernel_launch: memset failed\n"); return; }
    void* args[] = {&p};
    hipError_t e = hipLaunchCooperativeKernel((const void*)fwd_kernel, dim3(grid), dim3(512), args, LDS_BYTES, stream);
    if (e != hipSuccess) fprintf(stderr, "cooperative launch failed: %s (grid %d)\n", hipGetErrorString(e), grid);
}
```

```cpp
#include <hip/hip_runtime.h>
#include <hip/hip_cooperative_groups.h>
#include <cstdio>
#include <cstdint>
namespace cg = cooperative_groups;

#define LAS __attribute__((address_space(3)))
#define GAS __attribute__((address_space(1)))
typedef unsigned short bf16_t;
typedef short bf16x8 __attribute__((ext_vector_type(8)));
typedef short s16x4 __attribute__((ext_vector_type(4)));
typedef float f32x4 __attribute__((ext_vector_type(4)));
typedef float f32x2 __attribute__((ext_vector_type(2)));
typedef float f32x16 __attribute__((ext_vector_type(16)));
typedef unsigned u32x4 __attribute__((ext_vector_type(4)));
typedef unsigned u32x2 __attribute__((ext_vector_type(2)));
typedef __bf16 bf16x2_t __attribute__((ext_vector_type(2)));

constexpr int BATCH = 8, SEQ = 2048, DM = 1024, MTOK = BATCH * SEQ;
constexpr int NIN = 7680, DFF = 2816, NF1 = 2 * DFF;
constexpr int NGRP = 3, NHEAD = 8, HD = 64, QKVW = 1536, CCH = 512, CW = 31;
constexpr float EPS = 1e-6f;
constexpr float LOG2E = 1.4426950408889634f;
constexpr float QSCALE = 0.125f * LOG2E;

constexpr size_t MiB = 1u << 20;
constexpr size_t WS_CTL = 0, CTL_BYTES = 64 * 1024;
constexpr size_t WS_WIN = 1 * MiB;
constexpr size_t WS_WCAT = 16 * MiB;
constexpr size_t WS_WOUT = 18 * MiB;
constexpr size_t WS_WF1 = 20 * MiB;
constexpr size_t WS_WF2 = 31 * MiB;
constexpr size_t WS_SSQ = 37 * MiB;
constexpr size_t WS_ROPE = 38 * MiB;
constexpr size_t WS_Q = 40 * MiB;
constexpr size_t WS_K = 88 * MiB;
constexpr size_t WS_V = 136 * MiB;
constexpr size_t WS_GATE = 184 * MiB;
constexpr size_t WS_T = 40 * MiB;
constexpr size_t WS_Z = 104 * MiB;
constexpr size_t WS_X1B = 40 * MiB;
constexpr size_t WS_ACT = 72 * MiB;
constexpr size_t WS_END = 248 * MiB;
constexpr size_t DO_H = 0;
constexpr size_t DO_U = 32 * MiB;
constexpr size_t DO_AU = 0;

constexpr int LDS_MISC = 0, LDS_SCR = 1024, LDS_BYTES = 1024 + 139264;

__device__ __forceinline__ unsigned cvtpk(float lo, float hi) { f32x2 v = {lo, hi}; bf16x2_t b = __builtin_convertvector(v, bf16x2_t); return __builtin_bit_cast(unsigned, b); }
__device__ __forceinline__ float bf_lo(unsigned w) { return __uint_as_float(w << 16); }
__device__ __forceinline__ float bf_hi(unsigned w) { return __uint_as_float(w & 0xffff0000u); }
__device__ __forceinline__ float sigmoidf_(float x) { return __builtin_amdgcn_rcpf(1.0f + __builtin_amdgcn_exp2f(-x * LOG2E)); }
__device__ __forceinline__ float wave_sum(float v) {
#pragma unroll
    for (int o = 1; o < 64; o <<= 1) v += __shfl_xor(v, o);
    return v;
}
#define LDS_WAIT() asm volatile("s_waitcnt lgkmcnt(0)" ::: "memory")
#define VM_WAIT() asm volatile("s_waitcnt vmcnt(0)" ::: "memory")

__host__ __device__ __forceinline__ int pos2dim(int p) { return p < 16 ? (4 * (p >> 3) + 8 * ((p >> 2) & 1) + (p & 3)) : p; }
__host__ __device__ __forceinline__ int perm32(int rho) { const int n = rho >> 4, i = rho & 15; return 8 * (i >> 2) + 4 * n + (i & 3); }

namespace pg8 {
constexpr int BM = 256, BK = 64, HALF = 128, HTB = HALF * BK * 2, STAGE_BYTES = 8 * HTB, NXCD = 8, WGM = 4;
__host__ __device__ __forceinline__ int lds_byte(int r, int c) { const int st = (r >> 4) * 2 + (c >> 5), rr = r & 15, cc = c & 31, ob = rr * 64 + cc * 2; return st * 1024 + (ob ^ (((ob >> 9) & 1) << 5)); }
__host__ __device__ __forceinline__ void stage_rc(int b, int& R, int& C) { const int st = b / 1024, sb = b % 1024, swz = sb ^ (((sb >> 9) & 1) << 5); R = (st >> 1) * 16 + swz / 64; C = (st & 1) * 32 + (swz % 64) / 2; }

struct Unit { int pm, pn, kind; };
struct Gemm { const bf16_t* A; const bf16_t* Bt; int lda, ldb, K, koff; };

struct StaticOrder {
    int nM, nN, nwg, G, c, nkind;
    __device__ void init(int M, int N, int G_, int c_, int nkind_ = 1) { nM = M / BM; nN = N / BM; nwg = nM * nN; G = G_; c = c_; nkind = nkind_; }
    __device__ bool tile(long L, Unit& u) const {
        if (L >= nwg) return false;
        int wgid = (int)L; { const int q = nwg / NXCD, r = nwg % NXCD, xcd = wgid % NXCD, off = wgid / NXCD; wgid = (xcd < r ? xcd * (q + 1) : r * (q + 1) + (xcd - r) * q) + off; }
        const int nig = WGM * nN, gid = wgid / nig, fm = gid * WGM, gsz = (nM - fm) < WGM ? (nM - fm) : WGM;
        u.pm = fm + ((wgid % nig) % gsz); u.pn = (wgid % nig) / gsz; return true;
    }
    __device__ bool next(int i, Unit& u) const {
        if (nkind == 1) { u.kind = 0; return tile((long)i * G + c, u); }
        u.kind = i & 1; return tile((long)(i >> 1) * G + c, u);
    }
};

template <class Epi, class Sched>
__device__ __forceinline__ void gemm_phase(LAS unsigned char* lds, const Gemm g, const Sched& S, const Epi& E) {
    int tid = threadIdx.x; asm volatile("" : "+v"(tid));
    const int wid = __builtin_amdgcn_readfirstlane(tid >> 6), lane = tid & 63, wr = wid >> 2, wc = wid & 3, fr = lane & 15, fq = lane >> 4;
    const int nt = g.K / BK;
    unsigned voffA[2], voffB[2];
#pragma unroll
    for (int i = 0; i < 2; ++i) { int R, C; stage_rc(tid * 16 + i * 8192, R, C); voffA[i] = (unsigned)(R * g.lda + C) * 2u; voffB[i] = (unsigned)(R * g.ldb + C) * 2u; }
    const size_t kstep = (size_t)(BK * 2);
    const size_t hstepA = (size_t)HALF * g.lda * 2, hstepB = (size_t)HALF * g.ldb * 2;
    const size_t tstepA = 2 * hstepA, tstepB = 2 * hstepB;
    const unsigned ldsw = (unsigned)wid * 1024u;
    const int aoff = lds_byte(wr * 64 + fr, fq * 8), boff = lds_byte(wc * 32 + fr, fq * 8);
#define PG8_SA(b, h) (((b) * 2 + (h)) * HTB)
#define PG8_SB(b, h) ((4 + (b) * 2 + (h)) * HTB)
#define PG8_STAGE(bufoff, gbase, voff) do { _Pragma("unroll") for (int _i = 0; _i < 2; ++_i) \
        __builtin_amdgcn_global_load_lds((const unsigned*)((const char*)(gbase) + (voff)[_i]), (LAS unsigned*)(lds + (bufoff) + ldsw + _i * 8192), 16, 0, 0); } while (0)
#define PG8_LDA(dst, b, h) do { _Pragma("unroll") for (int m = 0; m < 4; ++m) _Pragma("unroll") for (int k = 0; k < 2; ++k) dst[m][k] = *(const LAS bf16x8*)(lds + PG8_SA(b, h) + aoff + m * 2048 + k * 1024); } while (0)
#define PG8_LDB(dst, b, h) do { _Pragma("unroll") for (int n = 0; n < 2; ++n) _Pragma("unroll") for (int k = 0; k < 2; ++k) dst[n][k] = *(const LAS bf16x8*)(lds + PG8_SB(b, h) + boff + n * 2048 + k * 1024); } while (0)
#define PG8_MMA(ai, bj, At, Bt) do { __builtin_amdgcn_s_setprio(1); _Pragma("unroll") for (int m = 0; m < 4; ++m) _Pragma("unroll") for (int n = 0; n < 2; ++n) _Pragma("unroll") for (int k = 0; k < 2; ++k) \
        acc[ai][bj][m][n] = __builtin_amdgcn_mfma_f32_16x16x32_bf16(Bt[n][k], At[m][k], acc[ai][bj][m][n], 0, 0, 0); __builtin_amdgcn_s_setprio(0); } while (0)
#define PG8_WAIT_V(n) asm volatile("s_waitcnt vmcnt(" #n ")" ::: "memory")
#define PG8_WAIT_L(n) asm volatile("s_waitcnt lgkmcnt(" #n ")" ::: "memory")
#define PG8_BAR __builtin_amdgcn_s_barrier()
#define PG8_SCHED __builtin_amdgcn_sched_barrier(0)
    Unit cur, nxt; int ui = 0;
    if (!S.next(0, cur)) return;
    f32x4 acc[2][2][4][2];
#pragma unroll
    for (int a = 0; a < 2; ++a)
#pragma unroll
        for (int b = 0; b < 2; ++b)
#pragma unroll
            for (int m = 0; m < 4; ++m)
#pragma unroll
                for (int n = 0; n < 2; ++n) acc[a][b][m][n] = (f32x4){0.f, 0.f, 0.f, 0.f};
    bf16x8 At[4][2], B0[2][2], B1[2][2];
    const char* cA = (const char*)g.A + (size_t)cur.pm * tstepA + (size_t)cur.kind * g.koff * 2;
    const char* cB = (const char*)g.Bt + (size_t)cur.pn * tstepB + (size_t)cur.kind * g.koff * 2;
    PG8_STAGE(PG8_SB(0, 0), cB, voffB); PG8_STAGE(PG8_SB(0, 1), cB + hstepB, voffB); PG8_STAGE(PG8_SA(0, 0), cA, voffA); PG8_STAGE(PG8_SA(0, 1), cA + hstepA, voffA);
    if (wr == 1) PG8_BAR;
    PG8_WAIT_V(2); PG8_BAR;
    PG8_STAGE(PG8_SB(1, 0), cB + kstep, voffB); PG8_STAGE(PG8_SA(1, 0), cA + kstep, voffA); PG8_STAGE(PG8_SB(1, 1), cB + hstepB + kstep, voffB);
    PG8_WAIT_V(6); PG8_BAR;
    for (;;) {
        const bool has_next = S.next(ui + 1, nxt);
        const char* nA = has_next ? (const char*)g.A + (size_t)nxt.pm * tstepA + (size_t)nxt.kind * g.koff * 2 : cA;
        const char* nB = has_next ? (const char*)g.Bt + (size_t)nxt.pn * tstepB + (size_t)nxt.kind * g.koff * 2 : cB;
        for (int t = 0; t < nt; t += 2) {
            const bool last = (t == nt - 2);
            const char* a1 = cA + (size_t)(t + 1) * kstep;
            const char* a2 = last ? nA : cA + (size_t)(t + 2) * kstep; const char* b2 = last ? nB : cB + (size_t)(t + 2) * kstep;
            const char* a3 = a2 + kstep; const char* b3 = b2 + kstep;
            PG8_LDB(B0, 0, 0); PG8_LDB(B1, 0, 1); PG8_SCHED; PG8_LDA(At, 0, 0); PG8_STAGE(PG8_SA(1, 1), a1 + hstepA, voffA);
            PG8_WAIT_V(8); PG8_WAIT_L(0); PG8_BAR; PG8_MMA(0, 0, At, B0); PG8_MMA(0, 1, At, B1); PG8_BAR; PG8_SCHED;
            PG8_LDA(At, 0, 1); PG8_STAGE(PG8_SB(0, 0), b2, voffB); PG8_STAGE(PG8_SB(0, 1), b2 + hstepB, voffB); PG8_STAGE(PG8_SA(0, 0), a2, voffA);
            PG8_WAIT_V(8); PG8_WAIT_L(0); PG8_BAR; PG8_MMA(1, 0, At, B0); PG8_MMA(1, 1, At, B1); PG8_BAR; PG8_SCHED;
            PG8_LDB(B0, 1, 0); PG8_LDB(B1, 1, 1); PG8_SCHED; PG8_LDA(At, 1, 0); PG8_STAGE(PG8_SA(0, 1), a2 + hstepA, voffA);
            PG8_WAIT_V(8); PG8_WAIT_L(0); PG8_BAR; PG8_MMA(0, 0, At, B0); PG8_MMA(0, 1, At, B1); PG8_BAR; PG8_SCHED;
            PG8_LDA(At, 1, 1); PG8_STAGE(PG8_SB(1, 0), b3, voffB); PG8_STAGE(PG8_SB(1, 1), b3 + hstepB, voffB); PG8_STAGE(PG8_SA(1, 0), a3, voffA);
            PG8_WAIT_V(8); PG8_WAIT_L(0); PG8_BAR; PG8_MMA(1, 0, At, B0); PG8_MMA(1, 1, At, B1); PG8_BAR; PG8_SCHED;
        }
        if (wr == 0) PG8_BAR;
        const bool keep = E(acc, cur, wr, wc, fr, fq);
        if (!has_next) break;
        if (!keep)
#pragma unroll
        for (int a = 0; a < 2; ++a)
#pragma unroll
            for (int b = 0; b < 2; ++b)
#pragma unroll
                for (int m = 0; m < 4; ++m)
#pragma unroll
                    for (int n = 0; n < 2; ++n) acc[a][b][m][n] = (f32x4){0.f, 0.f, 0.f, 0.f};
        cur = nxt; cA = nA; cB = nB; ++ui;
        if (wr == 1) PG8_BAR;
    }
    PG8_WAIT_V(0);
    PG8_BAR;
#undef PG8_SA
#undef PG8_SB
#undef PG8_STAGE
#undef PG8_LDA
#undef PG8_LDB
#undef PG8_MMA
#undef PG8_WAIT_V
#undef PG8_WAIT_L
#undef PG8_BAR
#undef PG8_SCHED
}
}

typedef f32x4 AccT[2][2][4][2];

struct EpiIn {
    bf16_t *Q, *Kb, *V, *U, *G; const float *qnw, *knw, *bgate, *rope;
    __device__ __forceinline__ bool operator()(AccT& acc, const pg8::Unit& u, int wr, int wc, int fr, int fq) const {
        const int pn = u.pn, tok0 = u.pm * 256 + wr * 64 + fr;
        if (pn < 18) {
            const int sec = pn / 6, pt = pn - sec * 6, g = pt >> 1, head = 4 * (pt & 1) + wc;
            const int dsh = 2 * g, Lg = SEQ >> dsh;
            bf16_t* dst = Q + (size_t)sec * ((WS_K - WS_Q) / 2);
            const float* nw = qnw; if (sec == 1) nw = knw;
            if (sec < 2) {
                const int d00 = fq < 2 ? 4 * fq : 8 * fq, d01 = fq < 2 ? 4 * fq + 8 : 8 * fq + 4;
                const f32x4 w00 = *(const f32x4*)(nw + d00), w01 = *(const f32x4*)(nw + d01), w10 = *(const f32x4*)(nw + 32 + 8 * fq), w11 = *(const f32x4*)(nw + 36 + 8 * fq);
                const float sc = sec == 0 ? QSCALE : 1.0f;
                const int fo = fq < 2 ? 4 * fq : 0;
#pragma unroll
                for (int ai = 0; ai < 2; ++ai) {
                    f32x4 csv[4], snv[4];
#pragma unroll
                    for (int m = 0; m < 4; ++m) { const float* rp = rope + (size_t)(tok0 + ai * 128 + m * 16) * 16 + fo; csv[m] = *(const f32x4*)rp; snv[m] = *(const f32x4*)(rp + 8); }
#pragma unroll
                    for (int m = 0; m < 4; ++m) {
                        const int tok = tok0 + ai * 128 + m * 16, b = tok >> 11, s = tok & (SEQ - 1);
                        f32x4 v00 = acc[ai][0][m][0], v01 = acc[ai][0][m][1], v10 = acc[ai][1][m][0], v11 = acc[ai][1][m][1];
                        float ss = 0.f;
#pragma unroll
                        for (int e = 0; e < 4; ++e) ss += v00[e] * v00[e] + v01[e] * v01[e] + v10[e] * v10[e] + v11[e] * v11[e];
                        ss += __shfl_xor(ss, 16); ss += __shfl_xor(ss, 32);
                        const float rstd = __builtin_amdgcn_rsqf(ss * (1.0f / 64.0f) + EPS);
                        v00 = v00 * rstd * w00; v01 = v01 * rstd * w01; v10 = v10 * rstd * w10; v11 = v11 * rstd * w11;
                        const f32x4 cs = csv[m], sn = snv[m];
                        const f32x4 t1 = v00 * cs - v01 * sn, t2 = v01 * cs + v00 * sn;
                        if (fq < 2) { v00 = t1; v01 = t2; }
                        v00 = v00 * sc; v01 = v01 * sc; v10 = v10 * sc; v11 = v11 * sc;
                        const size_t row = (size_t)((b * NGRP + g) * NHEAD + head) * SEQ + (size_t)(s & ((1 << dsh) - 1)) * Lg + (s >> dsh);
                        bf16_t* p = dst + row * HD + 8 * fq;
                        u32x4 o0, o1;
                        o0.x = cvtpk(v00[0], v00[1]); o0.y = cvtpk(v00[2], v00[3]); o0.z = cvtpk(v01[0], v01[1]); o0.w = cvtpk(v01[2], v01[3]);
                        o1.x = cvtpk(v10[0], v10[1]); o1.y = cvtpk(v10[2], v10[3]); o1.z = cvtpk(v11[0], v11[1]); o1.w = cvtpk(v11[2], v11[3]);
                        *(u32x4*)p = o0; *(u32x4*)(p + 32) = o1;
                    }
                }
            } else {
#pragma unroll
                for (int ai = 0; ai < 2; ++ai)
#pragma unroll
                    for (int m = 0; m < 4; ++m) {
                        const int tok = tok0 + ai * 128 + m * 16, b = tok >> 11, s = tok & (SEQ - 1);
                        const f32x4 v00 = acc[ai][0][m][0], v01 = acc[ai][0][m][1], v10 = acc[ai][1][m][0], v11 = acc[ai][1][m][1];
                        const size_t row = (size_t)((b * NGRP + g) * NHEAD + head) * SEQ + (size_t)(s & ((1 << dsh) - 1)) * Lg + (s >> dsh);
                        bf16_t* p = dst + row * HD + 8 * fq;
                        u32x4 o0, o1;
                        o0.x = cvtpk(v00[0], v00[1]); o0.y = cvtpk(v00[2], v00[3]); o0.z = cvtpk(v01[0], v01[1]); o0.w = cvtpk(v01[2], v01[3]);
                        o1.x = cvtpk(v10[0], v10[1]); o1.y = cvtpk(v10[2], v10[3]); o1.z = cvtpk(v11[0], v11[1]); o1.w = cvtpk(v11[2], v11[3]);
                        *(u32x4*)p = o0; *(u32x4*)(p + 32) = o1;
                    }
            }
        } else if (pn < 22) {
            const int ch0 = (pn - 18) * 128 + wc * 32 + 8 * fq;
#pragma unroll
            for (int ai = 0; ai < 2; ++ai)
#pragma unroll
                for (int m = 0; m < 4; ++m) {
                    const int tok = tok0 + ai * 128 + m * 16;
                    const f32x4 a0 = acc[ai][0][m][0], a1 = acc[ai][0][m][1], b0 = acc[ai][1][m][0], b1 = acc[ai][1][m][1];
                    f32x4 r0, r1;
#pragma unroll
                    for (int e = 0; e < 4; ++e) { r0[e] = a0[e] * sigmoidf_(b0[e]); r1[e] = a1[e] * sigmoidf_(b1[e]); }
                    u32x4 o; o.x = cvtpk(r0[0], r0[1]); o.y = cvtpk(r0[2], r0[3]); o.z = cvtpk(r1[0], r1[1]); o.w = cvtpk(r1[2], r1[3]);
                    *(u32x4*)(U + (size_t)tok * CCH + ch0) = o;
                }
        } else {
            const int c0 = (pn - 22) * 256 + wc * 32 + 8 * fq;
#pragma unroll
            for (int bj = 0; bj < 2; ++bj) {
                const f32x4 g0 = *(const f32x4*)(bgate + c0 + bj * 128), g1 = *(const f32x4*)(bgate + c0 + bj * 128 + 4);
#pragma unroll
                for (int ai = 0; ai < 2; ++ai)
#pragma unroll
                    for (int m = 0; m < 4; ++m) {
                        const int tok = tok0 + ai * 128 + m * 16;
                        const f32x4 a0 = acc[ai][bj][m][0] + g0, a1 = acc[ai][bj][m][1] + g1;
                        f32x4 r0, r1;
#pragma unroll
                        for (int e = 0; e < 4; ++e) { r0[e] = sigmoidf_(a0[e]); r1[e] = sigmoidf_(a1[e]); }
                        u32x4 o; o.x = cvtpk(r0[0], r0[1]); o.y = cvtpk(r0[2], r0[3]); o.z = cvtpk(r1[0], r1[1]); o.w = cvtpk(r1[2], r1[3]);
                        *(u32x4*)(G + (size_t)tok * 2048 + c0 + bj * 128) = o;
                    }
            }
        }
        return false;
    }
};

struct EpiMix {
    const bf16_t* G; bf16_t* Z;
    __device__ __forceinline__ bool operator()(AccT& acc, const pg8::Unit& u, int wr, int wc, int fr, int fq) const {
        const int tok0 = u.pm * 256 + wr * 64 + fr, c0 = u.pn * 256 + wc * 32 + 8 * fq;
        if (u.kind == 0) {
#pragma unroll
            for (int am = 0; am < 4; ++am) { const int ai = am >> 1;
                u32x4 ga[4][2], gb[4][2];
#pragma unroll
                for (int m = 2 * (am & 1); m < 2 * (am & 1) + 2; ++m)
#pragma unroll
                    for (int bj = 0; bj < 2; ++bj) { const bf16_t* gp = G + (size_t)(tok0 + ai * 128 + m * 16) * 2048 + c0 + bj * 128; ga[m][bj] = *(const u32x4*)gp; gb[m][bj] = *(const u32x4*)(gp + 1024); }
#pragma unroll
                for (int m = 2 * (am & 1); m < 2 * (am & 1) + 2; ++m)
#pragma unroll
                    for (int bj = 0; bj < 2; ++bj) {
                        const u32x4 wb = gb[m][bj], wa = ga[m][bj];
                        f32x4 b0 = {bf_lo(wb.x), bf_hi(wb.x), bf_lo(wb.y), bf_hi(wb.y)}, b1 = {bf_lo(wb.z), bf_hi(wb.z), bf_lo(wb.w), bf_hi(wb.w)};
                        const f32x4 a0 = {bf_lo(wa.x), bf_hi(wa.x), bf_lo(wa.y), bf_hi(wa.y)}, a1 = {bf_lo(wa.z), bf_hi(wa.z), bf_lo(wa.w), bf_hi(wa.w)};
#pragma unroll
                        for (int e = 0; e < 4; ++e) { b0[e] = fmaxf(b0[e], 1e-30f); b1[e] = fmaxf(b1[e], 1e-30f);
                            acc[ai][bj][m][0][e] *= a0[e] * __builtin_amdgcn_rcpf(b0[e]); acc[ai][bj][m][1][e] *= a1[e] * __builtin_amdgcn_rcpf(b1[e]); }
                    }
            }
        } else {
#pragma unroll
            for (int ai = 0; ai < 2; ++ai) {
                u32x4 gb[4][2];
#pragma unroll
                for (int m = 0; m < 4; ++m)
#pragma unroll
                    for (int bj = 0; bj < 2; ++bj) gb[m][bj] = *(const u32x4*)(G + (size_t)(tok0 + ai * 128 + m * 16) * 2048 + 1024 + c0 + bj * 128);
#pragma unroll
                for (int m = 0; m < 4; ++m)
#pragma unroll
                    for (int bj = 0; bj < 2; ++bj) {
                        const u32x4 wb = gb[m][bj];
                        f32x4 b0 = {bf_lo(wb.x), bf_hi(wb.x), bf_lo(wb.y), bf_hi(wb.y)}, b1 = {bf_lo(wb.z), bf_hi(wb.z), bf_lo(wb.w), bf_hi(wb.w)};
#pragma unroll
                        for (int e = 0; e < 4; ++e) { b0[e] = fmaxf(b0[e], 1e-30f); b1[e] = fmaxf(b1[e], 1e-30f); }
                        const f32x4 r0 = acc[ai][bj][m][0] * b0, r1 = acc[ai][bj][m][1] * b1;
                        u32x4 o; o.x = cvtpk(r0[0], r0[1]); o.y = cvtpk(r0[2], r0[3]); o.z = cvtpk(r1[0], r1[1]); o.w = cvtpk(r1[2], r1[3]);
                        *(u32x4*)(Z + (size_t)(tok0 + ai * 128 + m * 16) * DM + c0 + bj * 128) = o;
                    }
            }
        }
        return u.kind == 0;
    }
};

struct EpiOut {
    const float* X; bf16_t* X1B; float* SSQ;
    __device__ __forceinline__ bool operator()(AccT& acc, const pg8::Unit& u, int wr, int wc, int fr, int fq) const {
        const int tok0 = u.pm * 256 + wr * 64 + fr, c0 = u.pn * 256 + wc * 32 + 8 * fq;
#pragma unroll
        for (int am = 0; am < 4; ++am) { const int ai = am >> 1;
            f32x4 xv[4][2][2];
#pragma unroll
            for (int m = 2 * (am & 1); m < 2 * (am & 1) + 2; ++m)
#pragma unroll
                for (int bj = 0; bj < 2; ++bj) { const float* xp = X + (size_t)(tok0 + ai * 128 + m * 16) * DM + c0 + bj * 128; xv[m][bj][0] = *(const f32x4*)xp; xv[m][bj][1] = *(const f32x4*)(xp + 4); }
#pragma unroll
            for (int m = 2 * (am & 1); m < 2 * (am & 1) + 2; ++m) {
                const int tok = tok0 + ai * 128 + m * 16; float ss = 0.f;
#pragma unroll
                for (int bj = 0; bj < 2; ++bj) {
                    const size_t off = (size_t)tok * DM + c0 + bj * 128;
                    const f32x4 r0 = acc[ai][bj][m][0] + xv[m][bj][0], r1 = acc[ai][bj][m][1] + xv[m][bj][1];
                    u32x4 o; o.x = cvtpk(r0[0], r0[1]); o.y = cvtpk(r0[2], r0[3]); o.z = cvtpk(r1[0], r1[1]); o.w = cvtpk(r1[2], r1[3]);
                    *(u32x4*)(X1B + off) = o;
#pragma unroll
                    for (int e = 0; e < 4; ++e) ss += r0[e] * r0[e] + r1[e] * r1[e];
                }
                ss += __shfl_xor(ss, 16); ss += __shfl_xor(ss, 32);
                if (fq == 0) SSQ[(size_t)(u.pn * 4 + wc) * MTOK + tok] = ss;
            }
        }
        return false;
    }
};

struct EpiFfn1 {
    bf16_t* ACT; const LAS float* rtab; int pm0, pm1, pm2, pm3;
    __device__ __forceinline__ bool operator()(AccT& acc, const pg8::Unit& u, int wr, int wc, int fr, int fq) const {
        const int tok0 = u.pm * 256 + wr * 64 + fr, c0 = u.pn * 128 + wc * 32 + 8 * fq;
        const int sl = u.pm == pm1 ? 1 : (u.pm == pm2 ? 2 : (u.pm == pm3 ? 3 : 0));
        const LAS float* rt = rtab + sl * 256 + wr * 64 + fr;
#pragma unroll
        for (int ai = 0; ai < 2; ++ai)
#pragma unroll
            for (int m = 0; m < 4; ++m) {
                const int tok = tok0 + ai * 128 + m * 16;
                const float rstd = rt[ai * 128 + m * 16];
                const f32x4 a0 = acc[ai][0][m][0] * rstd, a1 = acc[ai][0][m][1] * rstd, b0 = acc[ai][1][m][0] * rstd, b1 = acc[ai][1][m][1] * rstd;
                f32x4 r0, r1;
#pragma unroll
                for (int e = 0; e < 4; ++e) { r0[e] = a0[e] * sigmoidf_(a0[e]) * b0[e]; r1[e] = a1[e] * sigmoidf_(a1[e]) * b1[e]; }
                u32x4 o; o.x = cvtpk(r0[0], r0[1]); o.y = cvtpk(r0[2], r0[3]); o.z = cvtpk(r1[0], r1[1]); o.w = cvtpk(r1[2], r1[3]);
                *(u32x4*)(ACT + (size_t)tok * DFF + c0) = o;
            }
        return false;
    }
};

struct EpiFfn1g {
    const float* SSQ; bf16_t* ACT;
    __device__ __forceinline__ bool operator()(AccT& acc, const pg8::Unit& u, int wr, int wc, int fr, int fq) const {
        const int tok0 = u.pm * 256 + wr * 64 + fr, c0 = u.pn * 128 + wc * 32 + 8 * fq;
        float rs[2][4];
#pragma unroll
        for (int ai = 0; ai < 2; ++ai)
#pragma unroll
            for (int m = 0; m < 4; ++m) { const int tok = tok0 + ai * 128 + m * 16; float ss = 0.f;
#pragma unroll
                for (int j = 0; j < 4; ++j) ss += SSQ[(size_t)(4 * fq + j) * MTOK + tok];
                rs[ai][m] = ss; }
#pragma unroll
        for (int ai = 0; ai < 2; ++ai)
#pragma unroll
            for (int m = 0; m < 4; ++m) { float ss = rs[ai][m]; ss += __shfl_xor(ss, 16); ss += __shfl_xor(ss, 32); rs[ai][m] = __builtin_amdgcn_rsqf(ss * (1.0f / DM) + EPS); }
#pragma unroll
        for (int ai = 0; ai < 2; ++ai)
#pragma unroll
            for (int m = 0; m < 4; ++m) {
                const int tok = tok0 + ai * 128 + m * 16;
                const float rstd = rs[ai][m];
                const f32x4 a0 = acc[ai][0][m][0] * rstd, a1 = acc[ai][0][m][1] * rstd, b0 = acc[ai][1][m][0] * rstd, b1 = acc[ai][1][m][1] * rstd;
                f32x4 r0, r1;
#pragma unroll
                for (int e = 0; e < 4; ++e) { r0[e] = a0[e] * sigmoidf_(a0[e]) * b0[e]; r1[e] = a1[e] * sigmoidf_(a1[e]) * b1[e]; }
                u32x4 o; o.x = cvtpk(r0[0], r0[1]); o.y = cvtpk(r0[2], r0[3]); o.z = cvtpk(r1[0], r1[1]); o.w = cvtpk(r1[2], r1[3]);
                *(u32x4*)(ACT + (size_t)tok * DFF + c0) = o;
            }
        return false;
    }
};

struct EpiFfn2 {
    const bf16_t* X1B; float* OUT;
    __device__ __forceinline__ bool operator()(AccT& acc, const pg8::Unit& u, int wr, int wc, int fr, int fq) const {
        const int tok0 = u.pm * 256 + wr * 64 + fr, c0 = u.pn * 256 + wc * 32 + 8 * fq;
#pragma unroll
        for (int ai = 0; ai < 2; ++ai) {
            u32x4 xw[4][2];
#pragma unroll
            for (int m = 0; m < 4; ++m)
#pragma unroll
                for (int bj = 0; bj < 2; ++bj) xw[m][bj] = *(const u32x4*)(X1B + (size_t)(tok0 + ai * 128 + m * 16) * DM + c0 + bj * 128);
#pragma unroll
            for (int m = 0; m < 4; ++m) {
                const int tok = tok0 + ai * 128 + m * 16;
#pragma unroll
                for (int bj = 0; bj < 2; ++bj) {
                    const size_t off = (size_t)tok * DM + c0 + bj * 128;
                    const u32x4 w = xw[m][bj];
                    const f32x4 x0 = {bf_lo(w.x), bf_hi(w.x), bf_lo(w.y), bf_hi(w.y)}, x1 = {bf_lo(w.z), bf_hi(w.z), bf_lo(w.w), bf_hi(w.w)};
                    *(f32x4*)(OUT + off) = acc[ai][bj][m][0] + x0; *(f32x4*)(OUT + off + 4) = acc[ai][bj][m][1] + x1;
                }
            }
        }
        return false;
    }
};

struct AttnRing { u32x4 kr[4]; u32x4 vr[4]; };
__device__ __forceinline__ void att_load(AttnRing& R, const bf16_t* K, const bf16_t* V, int voff, int kt, int klo, int khi) {
    if (kt >= klo && kt <= khi) {
        const bf16_t* kp = K + (voff + kt * 32 * HD); const bf16_t* vp = V + (voff + kt * 32 * HD);
#pragma unroll
        for (int i = 0; i < 4; ++i) R.kr[i] = *(const u32x4*)(kp + i * 8 * HD);
#pragma unroll
        for (int i = 0; i < 4; ++i) R.vr[i] = *(const u32x4*)(vp + i * 8 * HD);
    }
}
template <int KT>
__device__ __forceinline__ void att_step(const AttnRing& R, const bf16x8 (&qf)[4], int klo, int khi, LAS unsigned char* vst, int vwr, int trb0, int trb1,
                                         LAS unsigned char* kst, int kw0, int kw1, int krd, int kf_, int r32, int hi, f32x16 (&o)[2], float& lsum) {
    if (KT >= klo && KT <= khi) {
#pragma unroll
        for (int i = 0; i < 4; ++i) *(LAS u32x4*)(kst + ((i & 1) ? kw1 : kw0) + i * 1024) = R.kr[i];
#pragma unroll
        for (int i = 0; i < 4; ++i) *(LAS u32x4*)(vst + vwr + i * 1024) = R.vr[i];
        bf16x8 kf[4];
#pragma unroll
        for (int s = 0; s < 4; ++s) kf[s] = *(const LAS bf16x8*)(kst + krd + (((2 * s + hi) ^ kf_) << 4));
        f32x16 p = {0.f, 0.f, 0.f, 0.f, 0.f, 0.f, 0.f, 0.f, 0.f, 0.f, 0.f, 0.f, 0.f, 0.f, 0.f, 0.f};
#pragma unroll
        for (int s = 0; s < 4; ++s) p = __builtin_amdgcn_mfma_f32_32x32x16_bf16(kf[s], qf[s], p, 0, 0, 0);
#pragma unroll
        for (int r = 0; r < 16; ++r) { const int kk = (r & 3) + 8 * (r >> 2) + 4 * hi; float e = __builtin_amdgcn_exp2f(p[r]);
            if (KT == 0) e = (kk >= r32) ? e : 0.f;
            if (KT == 4) e = (kk <= r32) ? e : 0.f;
            p[r] = e; }
        lsum += ((p[0] + p[1]) + (p[2] + p[3])) + ((p[4] + p[5]) + (p[6] + p[7])) + (((p[8] + p[9]) + (p[10] + p[11])) + ((p[12] + p[13]) + (p[14] + p[15])));
        bf16x8 pb[2];
#pragma unroll
        for (int s = 0; s < 2; ++s) { u32x4 w; w.x = cvtpk(p[8 * s], p[8 * s + 1]); w.y = cvtpk(p[8 * s + 2], p[8 * s + 3]); w.z = cvtpk(p[8 * s + 4], p[8 * s + 5]); w.w = cvtpk(p[8 * s + 6], p[8 * s + 7]); pb[s] = __builtin_bit_cast(bf16x8, w); }
#pragma unroll
        for (int dt = 0; dt < 2; ++dt)
#pragma unroll
            for (int s = 0; s < 2; ++s) {
                const int tb = dt ? trb1 : trb0;
                const s16x4 lo = __builtin_bit_cast(s16x4, __builtin_amdgcn_ds_read_tr16_b64_v4i16((LAS s16x4*)(vst + tb + s * 2048)));
                const s16x4 hh = __builtin_bit_cast(s16x4, __builtin_amdgcn_ds_read_tr16_b64_v4i16((LAS s16x4*)(vst + tb + s * 2048 + 1024)));
                const bf16x8 vf = {lo[0], lo[1], lo[2], lo[3], hh[0], hh[1], hh[2], hh[3]};
                o[dt] = __builtin_amdgcn_mfma_f32_32x32x16_bf16(vf, pb[s], o[dt], 0, 0, 0);
            }
        LDS_WAIT();
    }
}
__device__ __forceinline__ int acc_row(int t) { return (t & 0xF0) | ((t + (t >> 4)) & 15); }
__device__ __forceinline__ void attn_merge(LAS float* accO, LAS float* accL, const f32x16 (&o)[2], float l, int tk, int hi, bool first) {
    if (tk >= 0) {
        const int row = acc_row(tk);
#pragma unroll
        for (int dt = 0; dt < 2; ++dt)
#pragma unroll
            for (int rg = 0; rg < 4; ++rg) {
                LAS f32x4* p = (LAS f32x4*)(accO + row * 68 + 32 * dt + 8 * rg + 4 * hi);
                f32x4 v = {o[dt][4 * rg], o[dt][4 * rg + 1], o[dt][4 * rg + 2], o[dt][4 * rg + 3]};
                if (!first) v = v + *p;
                *p = v;
            }
        if (hi == 0) { if (!first) l += accL[tk]; accL[tk] = l; }
    }
}
__device__ __forceinline__ void attn_finalize(const LAS float* accO, const LAS float* accL, bf16_t* AU, int b, int h, int chunk, int tid) {
    const int tk = tid >> 1, half = tid & 1;
    const float rl = 1.0f / accL[tk];
    const LAS f32x4* p = (const LAS f32x4*)(accO + acc_row(tk) * 68 + 32 * half);
    bf16_t* dst = AU + (size_t)(b * SEQ + 256 * chunk + tk) * DM + h * HD + 32 * half;
#pragma unroll
    for (int i = 0; i < 4; ++i) { const f32x4 a = p[2 * i] * rl, bb = p[2 * i + 1] * rl;
        u32x4 ov; ov.x = cvtpk(a[0], a[1]); ov.y = cvtpk(a[2], a[3]); ov.z = cvtpk(bb[0], bb[1]); ov.w = cvtpk(bb[2], bb[3]);
        *(u32x4*)(dst + 8 * i) = ov; }
}
struct AttnTile { size_t seq0; int Lg, q0; };
__device__ __forceinline__ AttnTile attn_desc(int j, int b, int h, int sc, int w) {
    AttnTile t;
    if (j < 2) { t.seq0 = (size_t)((b * NGRP + 2) * NHEAD + h) * SEQ + (size_t)(2 * w + j) * 128; t.Lg = 128; t.q0 = 32 * sc; }
    else { const int c = 2 * sc + ((j - 2) >> 1);
        if ((j & 1) == 0) { t.seq0 = (size_t)((b * NGRP + 0) * NHEAD + h) * SEQ; t.Lg = 2048; t.q0 = 256 * c + 32 * w; }
        else { t.seq0 = (size_t)((b * NGRP + 1) * NHEAD + h) * SEQ + (size_t)(w >> 1) * 512; t.Lg = 512; t.q0 = 64 * c + 32 * (w & 1); } }
    return t;
}
__device__ __forceinline__ void attn_super(const bf16_t* Q, const bf16_t* K, const bf16_t* V, bf16_t* AU, float negc, LAS unsigned char* scr, int item) {
    int tid = threadIdx.x; asm volatile("" : "+v"(tid));
    const int lane = tid & 63, w = __builtin_amdgcn_readfirstlane(tid >> 6), r32 = lane & 31, hi = lane >> 5;
    const int sc = item & 3, h = (item >> 2) & 7, b = item >> 5;
    LAS float* accO = (LAS float*)scr;
    LAS float* accL = (LAS float*)(scr + 256 * 68 * 4);
    LAS unsigned char* vst = scr + 256 * 68 * 4 + 1024 + w * 4096;
    const int vwr = (lane >> 3) * 128 + (((lane & 7) * 16) ^ (((lane >> 4) & 1) << 6));
    const int qsw = ((lane & 15) >> 3) & 1;
    const int trrow = (4 * hi + ((lane & 15) >> 2)) * 128 + ((lane >> 4) & 1) * 32 + (lane & 3) * 8;
    const int trb0 = trrow + 64 * qsw, trb1 = trrow + 64 * (1 - qsw);
    LAS unsigned char* kst = scr + 256 * 68 * 4 + 1024 + 32768 + w * 4096;
    const int kw0 = (lane >> 3) * 128 + (((lane & 7) ^ (lane >> 4)) << 4), kw1 = (lane >> 3) * 128 + (((lane & 7) ^ ((lane >> 4) + 4)) << 4);
    const int krd = r32 * 128, kf_ = (r32 >> 1) & 7;
    AttnRing R0, R1, R2;
    f32x16 og2[2]; float lg2 = 0.f;
    AttnTile cur = attn_desc(0, b, h, sc, w);
    int klo = cur.q0 >= 64 ? 0 : 2 - (cur.q0 >> 5), khi = ((cur.Lg - cur.q0 + 32) >> 5) > 4 ? 4 : ((cur.Lg - cur.q0 + 32) >> 5);
    int voff = ((int)cur.seq0 + cur.q0 - 64 + (lane >> 3)) * HD + (lane & 7) * 8;
    bf16x8 qf[4];
    att_load(R0, K, V, voff, 0, klo, khi); att_load(R1, K, V, voff, 1, klo, khi);
    { const bf16_t* qp = Q + (cur.seq0 + cur.q0 + r32) * HD + 8 * hi;
#pragma unroll
      for (int s = 0; s < 4; ++s) qf[s] = *(const bf16x8*)(qp + 16 * s); }
#pragma unroll 1
    for (int j = 0; j < 6; ++j) {
        f32x16 o[2]; float ls = 0.f;
#pragma unroll
        for (int r = 0; r < 16; ++r) { o[0][r] = 0.f; o[1][r] = 0.f; }
        att_load(R2, K, V, voff, 2, klo, khi);
        att_step<0>(R0, qf, klo, khi, vst, vwr, trb0, trb1, kst, kw0, kw1, krd, kf_, r32, hi, o, ls);
        att_load(R0, K, V, voff, 3, klo, khi);
        att_step<1>(R1, qf, klo, khi, vst, vwr, trb0, trb1, kst, kw0, kw1, krd, kf_, r32, hi, o, ls);
        att_load(R1, K, V, voff, 4, klo, khi);
        att_step<2>(R2, qf, klo, khi, vst, vwr, trb0, trb1, kst, kw0, kw1, krd, kf_, r32, hi, o, ls);
        const AttnTile nxt = attn_desc(j < 5 ? j + 1 : 5, b, h, sc, w);
        const int nklo = nxt.q0 >= 64 ? 0 : 2 - (nxt.q0 >> 5), nkhi = ((nxt.Lg - nxt.q0 + 32) >> 5) > 4 ? 4 : ((nxt.Lg - nxt.q0 + 32) >> 5);
        const int nvoff = ((int)nxt.seq0 + nxt.q0 - 64 + (lane >> 3)) * HD + (lane & 7) * 8;
        att_step<3>(R0, qf, klo, khi, vst, vwr, trb0, trb1, kst, kw0, kw1, krd, kf_, r32, hi, o, ls);
        if (j < 5) att_load(R0, K, V, nvoff, 0, nklo, nkhi);
        att_step<4>(R1, qf, klo, khi, vst, vwr, trb0, trb1, kst, kw0, kw1, krd, kf_, r32, hi, o, ls);
        if (j < 5) { att_load(R1, K, V, nvoff, 1, nklo, nkhi);
            const bf16_t* qp = Q + (nxt.seq0 + nxt.q0 + r32) * HD + 8 * hi;
#pragma unroll
            for (int s = 0; s < 4; ++s) qf[s] = *(const bf16x8*)(qp + 16 * s); }
        const float l = ls + __shfl_xor(ls, 32);
        int tq = threadIdx.x; asm volatile("" : "+v"(tq));
        const int r32m = tq & 31, him = (tq >> 5) & 1;
        if (j < 2) {
            attn_merge(accO, accL, o, l, r32m < 16 ? 16 * r32m + 2 * w + j : -1, him, true);
            if (j == 0) { og2[0] = o[0]; og2[1] = o[1]; lg2 = l; }
            else {
#pragma unroll
                for (int r = 0; r < 16; ++r) { const float m0 = __shfl_xor(o[0][r], 16), m1 = __shfl_xor(o[1][r], 16); if (r32m < 16) { og2[0][r] = m0; og2[1][r] = m1; } }
                const float ml = __shfl_xor(l, 16); if (r32m < 16) lg2 = ml;
            }
        } else if ((j & 1) == 0) {
            __syncthreads();
            attn_merge(accO, accL, o, l, 32 * w + r32m, him, false);
        } else {
            __syncthreads();
            attn_merge(accO, accL, o, l, 4 * (32 * (w & 1) + r32m) + (w >> 1), him, false);
            __syncthreads();
            attn_finalize(accO, accL, AU, b, h, 2 * sc + ((j - 3) >> 1), tq);
            __syncthreads();
            if (j == 3) attn_merge(accO, accL, og2, lg2, r32m >= 16 ? 16 * (r32m - 16) + 2 * w : 16 * r32m + 2 * w + 1, him, true);
        }
        cur = nxt; klo = nklo; khi = nkhi; voff = nvoff;
    }
}

__device__ __forceinline__ void conv_unit(const bf16_t* U, const float* cw, const float* cb, const float* lnw, const float* lnb, bf16_t* AU, LAS unsigned char* scr, int unit) {
    int tid = threadIdx.x; asm volatile("" : "+v"(tid));
    const int lane = tid & 63, w = tid >> 6;
    const int b = unit >> 5, s0 = (unit & 31) * 64;
    const int cp = tid & 255, tg = tid >> 8;
    LAS float* cbuf = (LAS float*)scr;
    unsigned win[62];
#pragma unroll
    for (int i = 0; i < 62; ++i) { const int s = s0 + 32 * tg - 15 + i; win[i] = (s >= 0 && s < SEQ) ? *(const unsigned*)(U + (size_t)(b * SEQ + s) * CCH + 2 * cp) : 0u; }
    f32x2 acc[32];
    const f32x2 bias = *(const f32x2*)(cb + 2 * cp);
#pragma unroll
    for (int k = 0; k < 32; ++k) acc[k] = bias;
#pragma unroll
    for (int j = 0; j < CW; ++j) {
        const f32x2 wj = *(const f32x2*)(cw + j * CCH + 2 * cp);
#pragma unroll
        for (int k = 0; k < 32; ++k) { acc[k].x += wj.x * bf_lo(win[k + j]); acc[k].y += wj.y * bf_hi(win[k + j]); }
    }
#pragma unroll
    for (int k = 0; k < 32; ++k) *(LAS f32x2*)(cbuf + (32 * tg + k) * 516 + 2 * cp) = acc[k];
    __syncthreads();
    const f32x4 g0 = *(const f32x4*)(lnw + 4 * lane), g1 = *(const f32x4*)(lnw + 256 + 4 * lane), e0 = *(const f32x4*)(lnb + 4 * lane), e1 = *(const f32x4*)(lnb + 256 + 4 * lane);
    f32x4 va[8], vc[8]; float sm[8], sq[8];
#pragma unroll
    for (int k = 0; k < 8; ++k) { const int t = 8 * w + k;
        va[k] = *(const LAS f32x4*)(cbuf + t * 516 + 4 * lane); vc[k] = *(const LAS f32x4*)(cbuf + t * 516 + 256 + 4 * lane);
        sm[k] = (va[k][0] + va[k][1]) + (va[k][2] + va[k][3]) + (vc[k][0] + vc[k][1]) + (vc[k][2] + vc[k][3]); }
#pragma unroll
    for (int o = 1; o < 64; o <<= 1)
#pragma unroll
        for (int k = 0; k < 8; ++k) sm[k] += __shfl_xor(sm[k], o);
#pragma unroll
    for (int k = 0; k < 8; ++k) { const float mean = sm[k] * (1.0f / CCH); va[k] = va[k] - mean; vc[k] = vc[k] - mean;
        sq[k] = (va[k][0] * va[k][0] + va[k][1] * va[k][1]) + (va[k][2] * va[k][2] + va[k][3] * va[k][3]) + (vc[k][0] * vc[k][0] + vc[k][1] * vc[k][1]) + (vc[k][2] * vc[k][2] + vc[k][3] * vc[k][3]); }
#pragma unroll
    for (int o = 1; o < 64; o <<= 1)
#pragma unroll
        for (int k = 0; k < 8; ++k) sq[k] += __shfl_xor(sq[k], o);
#pragma unroll
    for (int k = 0; k < 8; ++k) {
        const int t = 8 * w + k;
        const float rstd = __builtin_amdgcn_rsqf(sq[k] * (1.0f / CCH) + EPS);
        f32x4 a = va[k] * rstd * g0 + e0, c = vc[k] * rstd * g1 + e1;
#pragma unroll
        for (int e = 0; e < 4; ++e) { a[e] = a[e] * sigmoidf_(a[e]); c[e] = c[e] * sigmoidf_(c[e]); }
        bf16_t* dst = AU + (size_t)(b * SEQ + s0 + t) * DM + CCH;
        u32x2 oa, oc; oa.x = cvtpk(a[0], a[1]); oa.y = cvtpk(a[2], a[3]); oc.x = cvtpk(c[0], c[1]); oc.y = cvtpk(c[2], c[3]);
        *(u32x2*)(dst + 4 * lane) = oa; *(u32x2*)(dst + 256 + 4 * lane) = oc;
    }
    __syncthreads();
}

__device__ __forceinline__ void p0_load(const float* W, int N, int k0, int cbase, const float* kscale, f32x4 (&v)[8], int lane) {
#pragma unroll
    for (int i = 0; i < 8; ++i) { const int kk = 8 * i + (lane >> 3); v[i] = *(const f32x4*)(W + (size_t)(k0 + kk) * N + cbase + 4 * (lane & 7)); if (kscale) v[i] = v[i] * kscale[k0 + kk]; }
}
__device__ __forceinline__ void p0_store(const f32x4 (&v)[8], int k0, bool qkperm, bf16_t* WT, int ldo, int kdst, int rho0, LAS float* scr, int lane) {
#pragma unroll
    for (int i = 0; i < 8; ++i) { LAS float* d = scr + (8 * i + (lane >> 3)) * 33 + 4 * (lane & 7); d[0] = v[i][0]; d[1] = v[i][1]; d[2] = v[i][2]; d[3] = v[i][3]; }
    LDS_WAIT(); asm volatile("" ::: "memory");
    const int c = lane & 7;
#pragma unroll
    for (int j = 0; j < 4; ++j) {
        const int n = (lane >> 3) + 8 * j;
        int src = perm32(n); if (qkperm) src = pos2dim(src);
        const LAS float* sp = scr + (8 * c) * 33 + src;
        u32x4 o; o.x = cvtpk(sp[0 * 33], sp[1 * 33]); o.y = cvtpk(sp[2 * 33], sp[3 * 33]); o.z = cvtpk(sp[4 * 33], sp[5 * 33]); o.w = cvtpk(sp[6 * 33], sp[7 * 33]);
        *(u32x4*)(WT + (size_t)(rho0 + n) * ldo + kdst + k0 + 8 * c) = o;
    }
    LDS_WAIT(); asm volatile("" ::: "memory");
}

struct Params {
    const float* x; const int* pos; const float *norm1_w, *w_in, *b_gate, *q_norm_w, *k_norm_w, *w_o_attn, *conv_w, *conv_b, *conv_ln_w, *conv_ln_b, *w_pw_conv, *w_out, *norm2_w, *w_ffn_in, *w_ffn_out;
    float* out; unsigned char* ws;
};

__constant__ double c_invfreq[8] = {1.0, 0.19392274474868576, 0.03760603093086393, 0.007292664737217109, 0.001414213562373095, 0.0002742481756762073, 5.318295896944988e-05, 1.031338537721246e-05};

constexpr int I_IN = 16 * (NIN / 32), I_O = 8 * 32, I_PW = 8 * 32, I_OUT = 16 * 32, I_F1 = 16 * (NF1 / 32), I_F2 = (DFF / 64) * 32;
constexpr int P0_NITEMS = I_IN + I_O + I_PW + I_OUT + I_F1 + I_F2;
template <bool LOAD>
__device__ __forceinline__ void p0_item(const Params& P, int it, f32x4 (&v)[8], LAS float* scr, int lane) {
    unsigned char* ws = P.ws;
    int r = it;
    if (r < I_IN) {
        const int kb = r / (NIN / 32), gi = r % (NIN / 32), rho0 = gi * 32;
        const int pn = rho0 >> 8, bj = (rho0 >> 7) & 1, wc = (rho0 >> 5) & 3;
        int cbase; bool qk = false;
        if (pn < 18) { const int sec = pn / 6, pt = pn - sec * 6, g = pt >> 1, head = 4 * (pt & 1) + wc; cbase = sec * QKVW + g * 512 + head * 64 + 32 * bj; qk = (sec < 2) && (bj == 0); }
        else if (pn < 22) cbase = 3 * QKVW + 512 * bj + (pn - 18) * 128 + 32 * wc;
        else cbase = 3 * QKVW + 1024 + (pn - 22) * 256 + 128 * bj + 32 * wc;
        if (LOAD) p0_load(P.w_in, NIN, kb * 64, cbase, nullptr, v, lane); else p0_store(v, kb * 64, qk, (bf16_t*)(ws + WS_WIN), DM, 0, rho0, scr, lane);
        return; }
    r -= I_IN;
    if (r < I_O) { const int kb = r / 32, gi = r % 32; if (LOAD) p0_load(P.w_o_attn, DM, kb * 64, gi * 32, nullptr, v, lane); else p0_store(v, kb * 64, false, (bf16_t*)(ws + WS_WCAT), DM, 0, gi * 32, scr, lane); return; }
    r -= I_O;
    if (r < I_PW) { const int kb = r / 32, gi = r % 32; if (LOAD) p0_load(P.w_pw_conv, DM, kb * 64, gi * 32, nullptr, v, lane); else p0_store(v, kb * 64, false, (bf16_t*)(ws + WS_WCAT), DM, 512, gi * 32, scr, lane); return; }
    r -= I_PW;
    if (r < I_OUT) { const int kb = r / 32, gi = r % 32; if (LOAD) p0_load(P.w_out, DM, kb * 64, gi * 32, nullptr, v, lane); else p0_store(v, kb * 64, false, (bf16_t*)(ws + WS_WOUT), DM, 0, gi * 32, scr, lane); return; }
    r -= I_OUT;
    if (r < I_F1) {
        const int kb = r / (NF1 / 32), gi = r % (NF1 / 32), rho0 = gi * 32;
        const int pn = rho0 >> 8, bj = (rho0 >> 7) & 1, wc = (rho0 >> 5) & 3;
        if (LOAD) p0_load(P.w_ffn_in, NF1, kb * 64, DFF * bj + 128 * pn + 32 * wc, P.norm2_w, v, lane); else p0_store(v, kb * 64, false, (bf16_t*)(ws + WS_WF1), DM, 0, rho0, scr, lane);
        return; }
    r -= I_F1;
    { const int kb = r / 32, gi = r % 32; if (LOAD) p0_load(P.w_ffn_out, DM, kb * 64, gi * 32, nullptr, v, lane); else p0_store(v, kb * 64, false, (bf16_t*)(ws + WS_WF2), DFF, 0, gi * 32, scr, lane); }
}

__device__ __forceinline__ void p0_weights(const Params& P, LAS float* scr, int lane, int iw, int nw, int lo, int hi) {
    f32x4 va[8], vb[8];
    int it = lo + iw;
    if (it < hi) p0_item<true>(P, it, va, scr, lane);
    while (it < hi) {
        const int nx = it + nw;
        if (nx < hi) p0_item<true>(P, nx, vb, scr, lane);
        p0_item<false>(P, it, va, scr, lane);
        it = nx;
        if (it >= hi) break;
        const int nx2 = it + nw;
        if (nx2 < hi) p0_item<true>(P, nx2, va, scr, lane);
        p0_item<false>(P, it, vb, scr, lane);
        it = nx2;
    }
}
__device__ __forceinline__ void p0_prologue(const Params& P, LAS unsigned char* scrb, int vcu, int G) {
    int tid = threadIdx.x; asm volatile("" : "+v"(tid));
    const int lane = tid & 63, wave = tid >> 6;
    LAS float* scr = (LAS float*)(scrb + wave * 16384);
    const int gw = vcu * 8 + wave, NGW = G * 8;
    unsigned char* ws = P.ws;
    bf16_t* Hn = (bf16_t*)((unsigned char*)P.out + DO_H);
    { f32x4 nw[4];
#pragma unroll
      for (int j = 0; j < 4; ++j) nw[j] = *((const f32x4*)P.norm1_w + lane + 64 * j);
      for (int m0 = gw; m0 < MTOK; m0 += 4 * NGW) {
        f32x4 v[4][4];
#pragma unroll
        for (int q = 0; q < 4; ++q) { const int m = m0 + q * NGW; if (m < MTOK) { const f32x4* xr = (const f32x4*)(P.x + (size_t)m * DM) + lane;
#pragma unroll
            for (int j = 0; j < 4; ++j) v[q][j] = xr[64 * j]; } }
#pragma unroll
        for (int q = 0; q < 4; ++q) { const int m = m0 + q * NGW; if (m < MTOK) {
            float s = 0.f;
#pragma unroll
            for (int j = 0; j < 4; ++j) s += (v[q][j][0] * v[q][j][0] + v[q][j][1] * v[q][j][1]) + (v[q][j][2] * v[q][j][2] + v[q][j][3] * v[q][j][3]);
            const float rstd = __builtin_amdgcn_rsqf(wave_sum(s) * (1.0f / DM) + EPS);
            u32x2* o8 = (u32x2*)(Hn + (size_t)m * DM) + lane;
#pragma unroll
            for (int j = 0; j < 4; ++j) { const f32x4 y = v[q][j] * rstd * nw[j]; u32x2 o; o.x = cvtpk(y[0], y[1]); o.y = cvtpk(y[2], y[3]); o8[64 * j] = o; } } }
      } }
    p0_weights(P, scr, lane, gw, NGW, 0, I_IN);
    float* rope = (float*)(ws + WS_ROPE);
    for (int i = vcu * 512 + tid; i < MTOK * 8; i += G * 512) {
        const int tok = i >> 3, f = i & 7;
        const double ang = (double)P.pos[tok] * c_invfreq[f];
        const double kq = __builtin_rint(ang * 0.15915494309189535);
        const double xr = __builtin_fma(-kq, 6.283185307179586, ang) - kq * 2.4492935982947064e-16;
        const double x2 = xr * xr;
        double sn = 1.0, cs = 1.0;
#pragma unroll
        for (int n = 12; n >= 1; --n) { sn = 1.0 - sn * x2 / (double)((2 * n) * (2 * n + 1)); cs = 1.0 - cs * x2 / (double)((2 * n - 1) * (2 * n)); }
        sn *= xr;
        rope[(size_t)tok * 16 + f] = (float)cs; rope[(size_t)tok * 16 + 8 + f] = (float)sn;
    }
}

#define RLX_AGENT __ATOMIC_RELAXED, __HIP_MEMORY_SCOPE_AGENT
#define XB_TMO      128
#define XB_XCNT(j)  (256  + 64 * (j))
#define XB_XSUB(j)  (1280 + 64 * (j))
#define XB_XGEN(j)  (2304 + 64 * (j))
#define XB_TOP      3328
#define XB_TOPGEN   3392
#define XCD_BAR_WORDS 3456
#define XB_SPIN_CAP (1u << 18)
__device__ __forceinline__ unsigned xb_ld(unsigned* p)              { return __hip_atomic_load(p, __ATOMIC_RELAXED, __HIP_MEMORY_SCOPE_AGENT); }
__device__ __forceinline__ unsigned xb_add(unsigned* p, unsigned v) { return __hip_atomic_fetch_add(p, v, __ATOMIC_RELAXED, __HIP_MEMORY_SCOPE_AGENT); }
__device__ __forceinline__ unsigned xb_xcc_id() { return (unsigned)__builtin_amdgcn_s_getreg((3 << 11) | 20) & 0xFu; }
#define XB_SPIN(cond, bar) do { unsigned _sp = 0; while (cond) { __builtin_amdgcn_s_sleep(1); \
    if ((++_sp & 255u) == 0u) { if (xb_ld(&(bar)[XB_TMO])) break; if (_sp > XB_SPIN_CAP) { atomicAdd(&(bar)[XB_TMO], 1u); break; } } } } while (0)
struct XcdBarrier { unsigned* bar; unsigned x; volatile LAS unsigned* st; };
__device__ __forceinline__ XcdBarrier xcd_barrier_post(unsigned* bar, volatile LAS unsigned* st) {
    XcdBarrier b; b.bar = bar; b.x = xb_xcc_id(); b.st = st;
    if (threadIdx.x == 0) (void)xb_add(&bar[XB_XCNT(b.x)], 1u);
    return b;
}
__device__ __forceinline__ void xcd_barrier_complete(unsigned* bar, unsigned x, unsigned& nloc, unsigned& nx) {
    const unsigned G = gridDim.x * gridDim.y * gridDim.z;
    unsigned sum, cnt, mine, sp = 0u;
    for (;;) {
        sum = 0u; cnt = 0u; mine = 0u;
#pragma unroll
        for (unsigned j = 0; j < 16; ++j) { const unsigned c = xb_ld(&bar[XB_XCNT(j)]); sum += c; cnt += (c > 0u) ? 1u : 0u; mine = (j == x) ? c : mine; }
        if (sum == G) break;
        __builtin_amdgcn_s_sleep(1);
        if ((++sp & 255u) == 0u) { if (xb_ld(&bar[XB_TMO])) break; if (sp > XB_SPIN_CAP) { atomicAdd(&bar[XB_TMO], 1u); break; } }
    }
    nloc = mine > 0u ? mine : 1u; nx = cnt > 0u ? cnt : 1u;
}
__device__ __forceinline__ void xcd_barrier(const XcdBarrier& b) {
    asm volatile("s_waitcnt vmcnt(0)" ::: "memory");
    __syncthreads();
    if (threadIdx.x == 0) {
        unsigned* bar = b.bar;
        __builtin_amdgcn_s_waitcnt(0);
        unsigned nloc = b.st[0], nx = b.st[1];
        if (nloc == 0u) { xcd_barrier_complete(bar, b.x, nloc, nx); b.st[0] = nloc; b.st[1] = nx; }
        const unsigned old = xb_add(&bar[XB_XSUB(b.x)], 1u);
        const unsigned gen = old / nloc;
        if (old + 1u == (gen + 1u) * nloc) {
            __builtin_amdgcn_fence(__ATOMIC_RELEASE, "agent");
            asm volatile("s_waitcnt vmcnt(0)" ::: "memory");
            const unsigned og = xb_add(&bar[XB_TOP], 1u);
            const unsigned tg = og / nx;
            if (og + 1u == (tg + 1u) * nx) xb_add(&bar[XB_TOPGEN], 1u);
            else XB_SPIN(xb_ld(&bar[XB_TOPGEN]) == tg, bar);
            __builtin_amdgcn_fence(__ATOMIC_ACQUIRE, "agent");
            xb_add(&bar[XB_XGEN(b.x)], 1u);
            asm volatile("s_waitcnt vmcnt(0)" ::: "memory");
        } else {
            XB_SPIN(xb_ld(&bar[XB_XGEN(b.x)]) == gen, bar);
            __builtin_amdgcn_fence(__ATOMIC_ACQUIRE, "agent");
            asm volatile("s_waitcnt vmcnt(0)" ::: "memory");
        }
    }
    __syncthreads();
}

#ifndef REP_P0
#define REP_P0 1
#endif
#ifndef REP_P1
#define REP_P1 1
#endif
#ifndef REP_P2A
#define REP_P2A 1
#endif
#ifndef REP_P2C
#define REP_P2C 1
#endif
#ifndef REP_P3A
#define REP_P3A 1
#endif
#ifndef REP_P3B
#define REP_P3B 1
#endif
#ifndef REP_P3C
#define REP_P3C 1
#endif
#ifndef REP_P3D
#define REP_P3D 1
#endif
#ifndef PROBE_SPIN
#define PROBE_SPIN 0
#endif
#ifndef EXTRA_SYNC
#define EXTRA_SYNC 0
#endif
__global__ void __launch_bounds__(512, 2) fwd_kernel(Params P) {
    extern __shared__ __attribute__((aligned(16))) unsigned char lds_raw[];
    LAS unsigned char* lds = (LAS unsigned char*)lds_raw;
    LAS unsigned char* scr = lds + LDS_SCR;
    const int G = gridDim.x, bx = blockIdx.x;
    const int vcu = (G % 8 == 0) ? (bx % 8) * (G / 8) + bx / 8 : bx;
    unsigned char* ws = P.ws; unsigned char* ob = (unsigned char*)P.out;
    bf16_t* Qb = (bf16_t*)(ws + WS_Q); bf16_t* Kb = (bf16_t*)(ws + WS_K); bf16_t* Vb = (bf16_t*)(ws + WS_V); bf16_t* Gt = (bf16_t*)(ws + WS_GATE);
    bf16_t* Ub = (bf16_t*)(ob + DO_U); bf16_t* AU = (bf16_t*)(ob + DO_AU); bf16_t* Hn = (bf16_t*)(ob + DO_H);
    float* SSQ = (float*)(ws + WS_SSQ);

    if (threadIdx.x < 64) ((LAS unsigned*)(lds + LDS_MISC))[threadIdx.x] = 0u;
    __syncthreads();
    const XcdBarrier xbar = xcd_barrier_post((unsigned*)(ws + WS_CTL) + 4096, (volatile LAS unsigned*)(lds + LDS_MISC) + 8);
    unsigned long long tprev = PROBE_SPIN ? __builtin_amdgcn_s_memrealtime() : 0ull;
#define SEAM(k, dosync) do { if (dosync) xcd_barrier(xbar); if (PROBE_SPIN) { const unsigned long long now_ = __builtin_amdgcn_s_memrealtime(); \
        if (PROBE_SPIN == (k)) { const unsigned long long d_ = now_ - tprev; while (__builtin_amdgcn_s_memrealtime() - now_ < d_) __builtin_amdgcn_s_sleep(8); } \
        tprev = __builtin_amdgcn_s_memrealtime(); } } while (0)
    for (int rep = 0; rep < REP_P0; ++rep) p0_prologue(P, scr, vcu, G);
    for (int rep = 0; rep < EXTRA_SYNC; ++rep) xcd_barrier(xbar);
    SEAM(1, 1);

    { pg8::Gemm g{Hn, (const bf16_t*)(ws + WS_WIN), DM, DM, DM, 0}; pg8::StaticOrder S; S.init(MTOK, NIN, G, bx);
      EpiIn E{Qb, Kb, Vb, Ub, Gt, P.q_norm_w, P.k_norm_w, P.b_gate, (const float*)(ws + WS_ROPE)};
      for (int rep = 0; rep < REP_P1; ++rep) pg8::gemm_phase(scr, g, S, E);
      const int nun = (MTOK / 256) * (NIN / 256), rem = nun % G, nidle = rem ? G - rem : G, iw = rem ? bx - rem : bx;
      if (iw >= 0) { int tid = threadIdx.x; asm volatile("" : "+v"(tid));
          p0_weights(P, (LAS float*)(scr + (tid >> 6) * 16384), tid & 63, iw * 8 + (tid >> 6), nidle * 8, I_IN, P0_NITEMS); } }
    SEAM(2, 1);

    { float qm = 0.f, km = 0.f;
      for (int i = 0; i < HD; ++i) { qm = fmaxf(qm, fabsf(P.q_norm_w[i])); km = fmaxf(km, fabsf(P.k_norm_w[i])); }
      const float negc = -fminf(8.0f * qm * km * LOG2E, 60.0f);
      for (int rep = 0; rep < REP_P2A; ++rep) for (int it = vcu; it < BATCH * NHEAD * 4; it += G) attn_super(Qb, Kb, Vb, AU, negc, scr, it);
      for (int rep = 0; rep < REP_P2C; ++rep) for (int un = vcu; un < BATCH * 32; un += G) conv_unit(Ub, P.conv_w, P.conv_b, P.conv_ln_w, P.conv_ln_b, AU, scr, un); }
    SEAM(3, 1);

    { pg8::Gemm g{AU, (const bf16_t*)(ws + WS_WCAT), DM, DM, 512, 512}; pg8::StaticOrder S; S.init(MTOK, DM, G, bx, 2);
      EpiMix E{Gt, (bf16_t*)(ws + WS_Z)};
      for (int rep = 0; rep < REP_P3A; ++rep) pg8::gemm_phase(scr, g, S, E); }
    SEAM(4, 1);

    { pg8::Gemm g{(const bf16_t*)(ws + WS_Z), (const bf16_t*)(ws + WS_WOUT), DM, DM, DM, 0}; pg8::StaticOrder S; S.init(MTOK, DM, G, bx);
      EpiOut E{P.x, (bf16_t*)(ws + WS_X1B), SSQ};
      for (int rep = 0; rep < REP_P3B; ++rep) pg8::gemm_phase(scr, g, S, E); }
    SEAM(5, 1);

    { pg8::Gemm g{(const bf16_t*)(ws + WS_X1B), (const bf16_t*)(ws + WS_WF1), DM, DM, DM, 0}; pg8::StaticOrder S; S.init(MTOK, NF1, G, bx);
      int pml[4] = {-1, -1, -1, -1}, npm = 0; bool fits = true;
      { pg8::Unit u; for (int i = 0; S.next(i, u); ++i) { if (u.pm != pml[0] && u.pm != pml[1] && u.pm != pml[2] && u.pm != pml[3]) { if (npm < 4) { if (npm == 0) pml[0] = u.pm; else if (npm == 1) pml[1] = u.pm; else if (npm == 2) pml[2] = u.pm; else pml[3] = u.pm; ++npm; } else fits = false; } } }
      LAS float* rtab = (LAS float*)(scr + 131072);
      if (fits) {
          for (int idx = threadIdx.x; idx < npm * 256; idx += 512) { const int p = idx >> 8, pmv = p == 0 ? pml[0] : (p == 1 ? pml[1] : (p == 2 ? pml[2] : pml[3])), tok = pmv * 256 + (idx & 255);
              float ss = 0.f;
#pragma unroll
              for (int j = 0; j < 16; ++j) ss += SSQ[(size_t)j * MTOK + tok];
              rtab[idx] = __builtin_amdgcn_rsqf(ss * (1.0f / DM) + EPS); }
          __syncthreads();
          EpiFfn1 E{(bf16_t*)(ws + WS_ACT), rtab, pml[0], pml[1], pml[2], pml[3]};
          for (int rep = 0; rep < REP_P3C; ++rep) pg8::gemm_phase(scr, g, S, E);
      } else {
          EpiFfn1g E{SSQ, (bf16_t*)(ws + WS_ACT)};
          for (int rep = 0; rep < REP_P3C; ++rep) pg8::gemm_phase(scr, g, S, E);
      } }
    SEAM(6, 1);

    { pg8::Gemm g{(const bf16_t*)(ws + WS_ACT), (const bf16_t*)(ws + WS_WF2), DFF, DFF, DFF, 0}; pg8::StaticOrder S; S.init(MTOK, DM, G, bx);
      for (int rep = 1; rep < REP_P3D; ++rep) { EpiFfn2 E0{(const bf16_t*)(ws + WS_X1B), (float*)(ws + WS_GATE)}; pg8::gemm_phase(scr, g, S, E0); }
      EpiFfn2 E{(const bf16_t*)(ws + WS_X1B), P.out};
      pg8::gemm_phase(scr, g, S, E); }
    SEAM(7, 0);
}

extern "C" void kernel_launch(void* const* d_in, const int* in_sizes, int n_in, void* d_out, int out_size, void* d_ws, size_t ws_size, hipStream_t stream) {
    static int grid = 0;
    if (grid == 0) {
        if (n_in != 17 || out_size != MTOK * DM || ws_size < WS_END) { fprintf(stderr, "kernel_launch: unexpected shapes (n_in %d out %d ws %zu)\n", n_in, out_size, ws_size); grid = -1; return; }
        int dev = 0, cus = 0, per_cu = 0;
        hipGetDevice(&dev);
        hipDeviceGetAttribute(&cus, hipDeviceAttributeMultiprocessorCount, dev);
        hipFuncSetAttribute((const void*)fwd_kernel, hipFuncAttributeMaxDynamicSharedMemorySize, LDS_BYTES);
        hipOccupancyMaxActiveBlocksPerMultiprocessor(&per_cu, (const void*)fwd_kernel, 512, LDS_BYTES);
        if (per_cu < 1) { fprintf(stderr, "kernel_launch: occupancy query says %d blocks per CU\n", per_cu); grid = -1; return; }
        grid = cus * (per_cu < 1 ? 0 : 1);
        fprintf(stderr, "kernel_launch: grid %d (occupancy %d per CU)\n", grid, per_cu);
    }
    if (grid < 0) return;
    Params p{};
    p.x = (const float*)d_in[0]; p.pos = (const int*)d_in[1]; p.norm1_w = (const float*)d_in[2]; p.w_in = (const float*)d_in[3]; p.b_gate = (const float*)d_in[4];
    p.q_norm_w = (const float*)d_in[5]; p.k_norm_w = (const float*)d_in[6]; p.w_o_attn = (const float*)d_in[7]; p.conv_w = (const float*)d_in[8]; p.conv_b = (const float*)d_in[9];
    p.conv_ln_w = (const float*)d_in[10]; p.conv_ln_b = (const float*)d_in[11]; p.w_pw_conv = (const float*)d_in[12]; p.w_out = (const float*)d_in[13]; p.norm2_w = (const float*)d_in[14];
    p.w_ffn_in = (const float*)d_in[15]; p.w_ffn_out = (const float*)d_in[16]; p.out = (float*)d_out; p.ws = (unsigned char*)d_ws;
    if (hipMemsetAsync((char*)d_ws + WS_CTL, 0, CTL_BYTES, stream) != hipSuccess) { fprintf(stderr, "kernel_launch: memset failed\n"); return; }
    void* args[] = {&p};
    hipError_t e = hipLaunchCooperativeKernel((const void*)fwd_kernel, dim3(grid), dim3(512), args, LDS_BYTES, stream);
    if (e != hipSuccess) fprintf(stderr, "cooperative launch failed: %s (grid %d)\n", hipGetErrorString(e), grid);
}
```

```cpp
#include <hip/hip_runtime.h>
#include <hip/hip_cooperative_groups.h>
#include <cstdio>
#include <cstdint>
namespace cg = cooperative_groups;

#define LAS __attribute__((address_space(3)))
#define GAS __attribute__((address_space(1)))
typedef unsigned short bf16_t;
typedef short bf16x8 __attribute__((ext_vector_type(8)));
typedef short s16x4 __attribute__((ext_vector_type(4)));
typedef float f32x4 __attribute__((ext_vector_type(4)));
typedef float f32x2 __attribute__((ext_vector_type(2)));
typedef float f32x16 __attribute__((ext_vector_type(16)));
typedef unsigned u32x4 __attribute__((ext_vector_type(4)));
typedef unsigned u32x2 __attribute__((ext_vector_type(2)));
typedef __bf16 bf16x2_t __attribute__((ext_vector_type(2)));

constexpr int BATCH = 8, SEQ = 2048, DM = 1024, MTOK = BATCH * SEQ;
constexpr int NIN = 7680, DFF = 2816, NF1 = 2 * DFF;
constexpr int NGRP = 3, NHEAD = 8, HD = 64, QKVW = 1536, CCH = 512, CW = 31;
constexpr float EPS = 1e-6f;
constexpr float LOG2E = 1.4426950408889634f;
constexpr float QSCALE = 0.125f * LOG2E;

constexpr size_t MiB = 1u << 20;
constexpr size_t WS_CTL = 0, CTL_BYTES = 64 * 1024;
constexpr size_t WS_WIN = 1 * MiB;
constexpr size_t WS_WCAT = 16 * MiB;
constexpr size_t WS_WOUT = 18 * MiB;
constexpr size_t WS_WF1 = 20 * MiB;
constexpr size_t WS_WF2 = 31 * MiB;
constexpr size_t WS_SSQ = 37 * MiB;
constexpr size_t WS_ROPE = 38 * MiB;
constexpr size_t WS_Q = 40 * MiB;
constexpr size_t WS_K = 88 * MiB;
constexpr size_t WS_V = 136 * MiB;
constexpr size_t WS_GATE = 184 * MiB;
constexpr size_t WS_T = 40 * MiB;
constexpr size_t WS_Z = 104 * MiB;
constexpr size_t WS_X1B = 40 * MiB;
constexpr size_t WS_ACT = 72 * MiB;
constexpr size_t WS_END = 248 * MiB;
constexpr size_t DO_H = 0;
constexpr size_t DO_U = 32 * MiB;
constexpr size_t DO_AU = 0;

constexpr int LDS_MISC = 0, LDS_SCR = 1024, LDS_BYTES = 1024 + 139264;

__device__ __forceinline__ unsigned cvtpk(float lo, float hi) { f32x2 v = {lo, hi}; bf16x2_t b = __builtin_convertvector(v, bf16x2_t); return __builtin_bit_cast(unsigned, b); }
__device__ __forceinline__ float bf_lo(unsigned w) { return __uint_as_float(w << 16); }
__device__ __forceinline__ float bf_hi(unsigned w) { return __uint_as_float(w & 0xffff0000u); }
__device__ __forceinline__ float sigmoidf_(float x) { return __builtin_amdgcn_rcpf(1.0f + __builtin_amdgcn_exp2f(-x * LOG2E)); }
__device__ __forceinline__ float wave_sum(float v) {
#pragma unroll
    for (int o = 1; o < 64; o <<= 1) v += __shfl_xor(v, o);
    return v;
}
#define LDS_WAIT() asm volatile("s_waitcnt lgkmcnt(0)" ::: "memory")
#define VM_WAIT() asm volatile("s_waitcnt vmcnt(0)" ::: "memory")

__host__ __device__ __forceinline__ int pos2dim(int p) { return p < 16 ? (4 * (p >> 3) + 8 * ((p >> 2) & 1) + (p & 3)) : p; }
__host__ __device__ __forceinline__ int perm32(int rho) { const int n = rho >> 4, i = rho & 15; return 8 * (i >> 2) + 4 * n + (i & 3); }

namespace pg8 {
constexpr int BM = 256, BK = 64, HALF = 128, HTB = HALF * BK * 2, STAGE_BYTES = 8 * HTB, NXCD = 8, WGM = 4;
__host__ __device__ __forceinline__ int lds_byte(int r, int c) { const int st = (r >> 4) * 2 + (c >> 5), rr = r & 15, cc = c & 31, ob = rr * 64 + cc * 2; return st * 1024 + (ob ^ (((ob >> 9) & 1) << 5)); }
__host__ __device__ __forceinline__ void stage_rc(int b, int& R, int& C) { const int st = b / 1024, sb = b % 1024, swz = sb ^ (((sb >> 9) & 1) << 5); R = (st >> 1) * 16 + swz / 64; C = (st & 1) * 32 + (swz % 64) / 2; }

struct Unit { int pm, pn, kind; };
struct Gemm { const bf16_t* A; const bf16_t* Bt; int lda, ldb, K, koff; };

struct StaticOrder {
    int nM, nN, nwg, G, c, nkind;
    __device__ void init(int M, int N, int G_, int c_, int nkind_ = 1) { nM = M / BM; nN = N / BM; nwg = nM * nN; G = G_; c = c_; nkind = nkind_; }
    __device__ bool tile(long L, Unit& u) const {
        if (L >= nwg) return false;
        int wgid = (int)L; { const int q = nwg / NXCD, r = nwg % NXCD, xcd = wgid % NXCD, off = wgid / NXCD; wgid = (xcd < r ? xcd * (q + 1) : r * (q + 1) + (xcd - r) * q) + off; }
        const int nig = WGM * nN, gid = wgid / nig, fm = gid * WGM, gsz = (nM - fm) < WGM ? (nM - fm) : WGM;
        u.pm = fm + ((wgid % nig) % gsz); u.pn = (wgid % nig) / gsz; return true;
    }
    __device__ bool next(int i, Unit& u) const {
        if (nkind == 1) { u.kind = 0; return tile((long)i * G + c, u); }
        u.kind = i & 1; return tile((long)(i >> 1) * G + c, u);
    }
};

template <class Epi, class Sched>
__device__ __forceinline__ void gemm_phase(LAS unsigned char* lds, const Gemm g, const Sched& S, const Epi& E) {
    int tid = threadIdx.x; asm volatile("" : "+v"(tid));
    const int wid = __builtin_amdgcn_readfirstlane(tid >> 6), lane = tid & 63, wr = wid >> 2, wc = wid & 3, fr = lane & 15, fq = lane >> 4;
    const int nt = g.K / BK;
    unsigned voffA[2], voffB[2];
#pragma unroll
    for (int i = 0; i < 2; ++i) { int R, C; stage_rc(tid * 16 + i * 8192, R, C); voffA[i] = (unsigned)(R * g.lda + C) * 2u; voffB[i] = (unsigned)(R * g.ldb + C) * 2u; }
    const size_t kstep = (size_t)(BK * 2);
    const size_t hstepA = (size_t)HALF * g.lda * 2, hstepB = (size_t)HALF * g.ldb * 2;
    const size_t tstepA = 2 * hstepA, tstepB = 2 * hstepB;
    const unsigned ldsw = (unsigned)wid * 1024u;
    const int aoff = lds_byte(wr * 64 + fr, fq * 8), boff = lds_byte(wc * 32 + fr, fq * 8);
#define PG8_SA(b, h) (((b) * 2 + (h)) * HTB)
#define PG8_SB(b, h) ((4 + (b) * 2 + (h)) * HTB)
#define PG8_STAGE(bufoff, gbase, voff) do { _Pragma("unroll") for (int _i = 0; _i < 2; ++_i) \
        __builtin_amdgcn_global_load_lds((const unsigned*)((const char*)(gbase) + (voff)[_i]), (LAS unsigned*)(lds + (bufoff) + ldsw + _i * 8192), 16, 0, 0); } while (0)
#define PG8_LDA(dst, b, h) do { _Pragma("unroll") for (int m = 0; m < 4; ++m) _Pragma("unroll") for (int k = 0; k < 2; ++k) dst[m][k] = *(const LAS bf16x8*)(lds + PG8_SA(b, h) + aoff + m * 2048 + k * 1024); } while (0)
#define PG8_LDB(dst, b, h) do { _Pragma("unroll") for (int n = 0; n < 2; ++n) _Pragma("unroll") for (int k = 0; k < 2; ++k) dst[n][k] = *(const LAS bf16x8*)(lds + PG8_SB(b, h) + boff + n * 2048 + k * 1024); } while (0)
#define PG8_MMA(ai, bj, At, Bt) do { __builtin_amdgcn_s_setprio(1); _Pragma("unroll") for (int m = 0; m < 4; ++m) _Pragma("unroll") for (int n = 0; n < 2; ++n) _Pragma("unroll") for (int k = 0; k < 2; ++k) \
        acc[ai][bj][m][n] = __builtin_amdgcn_mfma_f32_16x16x32_bf16(Bt[n][k], At[m][k], acc[ai][bj][m][n], 0, 0, 0); __builtin_amdgcn_s_setprio(0); } while (0)
#define PG8_WAIT_V(n) asm volatile("s_waitcnt vmcnt(" #n ")" ::: "memory")
#define PG8_WAIT_L(n) asm volatile("s_waitcnt lgkmcnt(" #n ")" ::: "memory")
#define PG8_BAR __builtin_amdgcn_s_barrier()
#define PG8_SCHED __builtin_amdgcn_sched_barrier(0)
    Unit cur, nxt; int ui = 0;
    if (!S.next(0, cur)) return;
    f32x4 acc[2][2][4][2];
#pragma unroll
    for (int a = 0; a < 2; ++a)
#pragma unroll
        for (int b = 0; b < 2; ++b)
#pragma unroll
            for (int m = 0; m < 4; ++m)
#pragma unroll
                for (int n = 0; n < 2; ++n) acc[a][b][m][n] = (f32x4){0.f, 0.f, 0.f, 0.f};
    bf16x8 At[4][2], B0[2][2], B1[2][2];
    const char* cA = (const char*)g.A + (size_t)cur.pm * tstepA + (size_t)cur.kind * g.koff * 2;
    const char* cB = (const char*)g.Bt + (size_t)cur.pn * tstepB + (size_t)cur.kind * g.koff * 2;
    PG8_STAGE(PG8_SB(0, 0), cB, voffB); PG8_STAGE(PG8_SB(0, 1), cB + hstepB, voffB); PG8_STAGE(PG8_SA(0, 0), cA, voffA); PG8_STAGE(PG8_SA(0, 1), cA + hstepA, voffA);
    if (wr == 1) PG8_BAR;
    PG8_WAIT_V(2); PG8_BAR;
    PG8_STAGE(PG8_SB(1, 0), cB + kstep, voffB); PG8_STAGE(PG8_SA(1, 0), cA + kstep, voffA); PG8_STAGE(PG8_SB(1, 1), cB + hstepB + kstep, voffB);
    PG8_WAIT_V(6); PG8_BAR;
    for (;;) {
        const bool has_next = S.next(ui + 1, nxt);
        const char* nA = has_next ? (const char*)g.A + (size_t)nxt.pm * tstepA + (size_t)nxt.kind * g.koff * 2 : cA;
        const char* nB = has_next ? (const char*)g.Bt + (size_t)nxt.pn * tstepB + (size_t)nxt.kind * g.koff * 2 : cB;
        for (int t = 0; t < nt; t += 2) {
            const bool last = (t == nt - 2);
            const char* a1 = cA + (size_t)(t + 1) * kstep;
            const char* a2 = last ? nA : cA + (size_t)(t + 2) * kstep; const char* b2 = last ? nB : cB + (size_t)(t + 2) * kstep;
            const char* a3 = a2 + kstep; const char* b3 = b2 + kstep;
            PG8_LDB(B0, 0, 0); PG8_LDB(B1, 0, 1); PG8_SCHED; PG8_LDA(At, 0, 0); PG8_STAGE(PG8_SA(1, 1), a1 + hstepA, voffA);
            PG8_WAIT_V(8); PG8_WAIT_L(0); PG8_BAR; PG8_MMA(0, 0, At, B0); PG8_MMA(0, 1, At, B1); PG8_BAR; PG8_SCHED;
            PG8_LDA(At, 0, 1); PG8_STAGE(PG8_SB(0, 0), b2, voffB); PG8_STAGE(PG8_SB(0, 1), b2 + hstepB, voffB); PG8_STAGE(PG8_SA(0, 0), a2, voffA);
            PG8_WAIT_V(8); PG8_WAIT_L(0); PG8_BAR; PG8_MMA(1, 0, At, B0); PG8_MMA(1, 1, At, B1); PG8_BAR; PG8_SCHED;
            PG8_LDB(B0, 1, 0); PG8_LDB(B1, 1, 1); PG8_SCHED; PG8_LDA(At, 1, 0); PG8_STAGE(PG8_SA(0, 1), a2 + hstepA, voffA);
            PG8_WAIT_V(8); PG8_WAIT_L(0); PG8_BAR; PG8_MMA(0, 0, At, B0); PG8_MMA(0, 1, At, B1); PG8_BAR; PG8_SCHED;
            PG8_LDA(At, 1, 1); PG8_STAGE(PG8_SB(1, 0), b3, voffB); PG8_STAGE(PG8_SB(1, 1), b3 + hstepB, voffB); PG8_STAGE(PG8_SA(1, 0), a3, voffA);
            PG8_WAIT_V(8); PG8_WAIT_L(0); PG8_BAR; PG8_MMA(1, 0, At, B0); PG8_MMA(1, 1, At, B1); PG8_BAR; PG8_SCHED;
        }
        if (wr == 0) PG8_BAR;
        const bool keep = E(acc, cur, wr, wc, fr, fq);
        if (!has_next) break;
        if (!keep)
#pragma unroll
        for (int a = 0; a < 2; ++a)
#pragma unroll
            for (int b = 0; b < 2; ++b)
#pragma unroll
                for (int m = 0; m < 4; ++m)
#pragma unroll
                    for (int n = 0; n < 2; ++n) acc[a][b][m][n] = (f32x4){0.f, 0.f, 0.f, 0.f};
        cur = nxt; cA = nA; cB = nB; ++ui;
        if (wr == 1) PG8_BAR;
    }
    PG8_WAIT_V(0);
    PG8_BAR;
#undef PG8_SA
#undef PG8_SB
#undef PG8_STAGE
#undef PG8_LDA
#undef PG8_LDB
#undef PG8_MMA
#undef PG8_WAIT_V
#undef PG8_WAIT_L
#undef PG8_BAR
#undef PG8_SCHED
}
}

typedef f32x4 AccT[2][2][4][2];

struct EpiIn {
    bf16_t *Q, *Kb, *V, *U, *G; const float *qnw, *knw, *bgate, *rope;
    __device__ __forceinline__ bool operator()(AccT& acc, const pg8::Unit& u, int wr, int wc, int fr, int fq) const {
        const int pn = u.pn, tok0 = u.pm * 256 + wr * 64 + fr;
        if (pn < 18) {
            const int sec = pn / 6, pt = pn - sec * 6, g = pt >> 1, head = 4 * (pt & 1) + wc;
            const int dsh = 2 * g, Lg = SEQ >> dsh;
            bf16_t* dst = Q + (size_t)sec * ((WS_K - WS_Q) / 2);
            const float* nw = qnw; if (sec == 1) nw = knw;
            if (sec < 2) {
                const int d00 = fq < 2 ? 4 * fq : 8 * fq, d01 = fq < 2 ? 4 * fq + 8 : 8 * fq + 4;
                const f32x4 w00 = *(const f32x4*)(nw + d00), w01 = *(const f32x4*)(nw + d01), w10 = *(const f32x4*)(nw + 32 + 8 * fq), w11 = *(const f32x4*)(nw + 36 + 8 * fq);
                const float sc = sec == 0 ? QSCALE : 1.0f;
                const int fo = fq < 2 ? 4 * fq : 0;
#pragma unroll
                for (int ai = 0; ai < 2; ++ai) {
                    f32x4 csv[4], snv[4];
#pragma unroll
                    for (int m = 0; m < 4; ++m) { const float* rp = rope + (size_t)(tok0 + ai * 128 + m * 16) * 16 + fo; csv[m] = *(const f32x4*)rp; snv[m] = *(const f32x4*)(rp + 8); }
#pragma unroll
                    for (int m = 0; m < 4; ++m) {
                        const int tok = tok0 + ai * 128 + m * 16, b = tok >> 11, s = tok & (SEQ - 1);
                        f32x4 v00 = acc[ai][0][m][0], v01 = acc[ai][0][m][1], v10 = acc[ai][1][m][0], v11 = acc[ai][1][m][1];
                        float ss = 0.f;
#pragma unroll
                        for (int e = 0; e < 4; ++e) ss += v00[e] * v00[e] + v01[e] * v01[e] + v10[e] * v10[e] + v11[e] * v11[e];
                        ss += __shfl_xor(ss, 16); ss += __shfl_xor(ss, 32);
                        const float rstd = __builtin_amdgcn_rsqf(ss * (1.0f / 64.0f) + EPS);
                        v00 = v00 * rstd * w00; v01 = v01 * rstd * w01; v10 = v10 * rstd * w10; v11 = v11 * rstd * w11;
                        const f32x4 cs = csv[m], sn = snv[m];
                        const f32x4 t1 = v00 * cs - v01 * sn, t2 = v01 * cs + v00 * sn;
                        if (fq < 2) { v00 = t1; v01 = t2; }
                        v00 = v00 * sc; v01 = v01 * sc; v10 = v10 * sc; v11 = v11 * sc;
                        const size_t row = (size_t)((b * NGRP + g) * NHEAD + head) * SEQ + (size_t)(s & ((1 << dsh) - 1)) * Lg + (s >> dsh);
                        bf16_t* p = dst + row * HD + 8 * fq;
                        u32x4 o0, o1;
                        o0.x = cvtpk(v00[0], v00[1]); o0.y = cvtpk(v00[2], v00[3]); o0.z = cvtpk(v01[0], v01[1]); o0.w = cvtpk(v01[2], v01[3]);
                        o1.x = cvtpk(v10[0], v10[1]); o1.y = cvtpk(v10[2], v10[3]); o1.z = cvtpk(v11[0], v11[1]); o1.w = cvtpk(v11[2], v11[3]);
                        *(u32x4*)p = o0; *(u32x4*)(p + 32) = o1;
                    }
                }
            } else {
#pragma unroll
                for (int ai = 0; ai < 2; ++ai)
#pragma unroll
                    for (int m = 0; m < 4; ++m) {
                        const int tok = tok0 + ai * 128 + m * 16, b = tok >> 11, s = tok & (SEQ - 1);
                        const f32x4 v00 = acc[ai][0][m][0], v01 = acc[ai][0][m][1], v10 = acc[ai][1][m][0], v11 = acc[ai][1][m][1];
                        const size_t row = (size_t)((b * NGRP + g) * NHEAD + head) * SEQ + (size_t)(s & ((1 << dsh) - 1)) * Lg + (s >> dsh);
                        bf16_t* p = dst + row * HD + 8 * fq;
                        u32x4 o0, o1;
                        o0.x = cvtpk(v00[0], v00[1]); o0.y = cvtpk(v00[2], v00[3]); o0.z = cvtpk(v01[0], v01[1]); o0.w = cvtpk(v01[2], v01[3]);
                        o1.x = cvtpk(v10[0], v10[1]); o1.y = cvtpk(v10[2], v10[3]); o1.z = cvtpk(v11[0], v11[1]); o1.w = cvtpk(v11[2], v11[3]);
                        *(u32x4*)p = o0; *(u32x4*)(p + 32) = o1;
                    }
            }
        } else if (pn < 22) {
            const int ch0 = (pn - 18) * 128 + wc * 32 + 8 * fq;
#pragma unroll
            for (int ai = 0; ai < 2; ++ai)
#pragma unroll
                for (int m = 0; m < 4; ++m) {
                    const int tok = tok0 + ai * 128 + m * 16;
                    const f32x4 a0 = acc[ai][0][m][0], a1 = acc[ai][0][m][1], b0 = acc[ai][1][m][0], b1 = acc[ai][1][m][1];
                    f32x4 r0, r1;
#pragma unroll
                    for (int e = 0; e < 4; ++e) { r0[e] = a0[e] * sigmoidf_(b0[e]); r1[e] = a1[e] * sigmoidf_(b1[e]); }
                    u32x4 o; o.x = cvtpk(r0[0], r0[1]); o.y = cvtpk(r0[2], r0[3]); o.z = cvtpk(r1[0], r1[1]); o.w = cvtpk(r1[2], r1[3]);
                    *(u32x4*)(U + (size_t)tok * CCH + ch0) = o;
                }
        } else {
            const int c0 = (pn - 22) * 256 + wc * 32 + 8 * fq;
#pragma unroll
            for (int bj = 0; bj < 2; ++bj) {
                const f32x4 g0 = *(const f32x4*)(bgate + c0 + bj * 128), g1 = *(const f32x4*)(bgate + c0 + bj * 128 + 4);
#pragma unroll
                for (int ai = 0; ai < 2; ++ai)
#pragma unroll
                    for (int m = 0; m < 4; ++m) {
                        const int tok = tok0 + ai * 128 + m * 16;
                        const f32x4 a0 = acc[ai][bj][m][0] + g0, a1 = acc[ai][bj][m][1] + g1;
                        f32x4 r0, r1;
#pragma unroll
                        for (int e = 0; e < 4; ++e) { r0[e] = sigmoidf_(a0[e]); r1[e] = sigmoidf_(a1[e]); }
                        u32x4 o; o.x = cvtpk(r0[0], r0[1]); o.y = cvtpk(r0[2], r0[3]); o.z = cvtpk(r1[0], r1[1]); o.w = cvtpk(r1[2], r1[3]);
                        *(u32x4*)(G + (size_t)tok * 2048 + c0 + bj * 128) = o;
                    }
            }
        }
        return false;
    }
};

struct EpiMix {
    const bf16_t* G; bf16_t* Z;
    __device__ __forceinline__ bool operator()(AccT& acc, const pg8::Unit& u, int wr, int wc, int fr, int fq) const {
        const int tok0 = u.pm * 256 + wr * 64 + fr, c0 = u.pn * 256 + wc * 32 + 8 * fq;
        if (u.kind == 0) {
#pragma unroll
            for (int am = 0; am < 4; ++am) { const int ai = am >> 1;
                u32x4 ga[4][2], gb[4][2];
#pragma unroll
                for (int m = 2 * (am & 1); m < 2 * (am & 1) + 2; ++m)
#pragma unroll
                    for (int bj = 0; bj < 2; ++bj) { const bf16_t* gp = G + (size_t)(tok0 + ai * 128 + m * 16) * 2048 + c0 + bj * 128; ga[m][bj] = *(const u32x4*)gp; gb[m][bj] = *(const u32x4*)(gp + 1024); }
#pragma unroll
                for (int m = 2 * (am & 1); m < 2 * (am & 1) + 2; ++m)
#pragma unroll
                    for (int bj = 0; bj < 2; ++bj) {
                        const u32x4 wb = gb[m][bj], wa = ga[m][bj];
                        f32x4 b0 = {bf_lo(wb.x), bf_hi(wb.x), bf_lo(wb.y), bf_hi(wb.y)}, b1 = {bf_lo(wb.z), bf_hi(wb.z), bf_lo(wb.w), bf_hi(wb.w)};
                        const f32x4 a0 = {bf_lo(wa.x), bf_hi(wa.x), bf_lo(wa.y), bf_hi(wa.y)}, a1 = {bf_lo(wa.z), bf_hi(wa.z), bf_lo(wa.w), bf_hi(wa.w)};
#pragma unroll
                        for (int e = 0; e < 4; ++e) { b0[e] = fmaxf(b0[e], 1e-30f); b1[e] = fmaxf(b1[e], 1e-30f);
                            acc[ai][bj][m][0][e] *= a0[e] * __builtin_amdgcn_rcpf(b0[e]); acc[ai][bj][m][1][e] *= a1[e] * __builtin_amdgcn_rcpf(b1[e]); }
                    }
            }
        } else {
#pragma unroll
            for (int ai = 0; ai < 2; ++ai) {
                u32x4 gb[4][2];
#pragma unroll
                for (int m = 0; m < 4; ++m)
#pragma unroll
                    for (int bj = 0; bj < 2; ++bj) gb[m][bj] = *(const u32x4*)(G + (size_t)(tok0 + ai * 128 + m * 16) * 2048 + 1024 + c0 + bj * 128);
#pragma unroll
                for (int m = 0; m < 4; ++m)
#pragma unroll
                    for (int bj = 0; bj < 2; ++bj) {
                        const u32x4 wb = gb[m][bj];
                        f32x4 b0 = {bf_lo(wb.x), bf_hi(wb.x), bf_lo(wb.y), bf_hi(wb.y)}, b1 = {bf_lo(wb.z), bf_hi(wb.z), bf_lo(wb.w), bf_hi(wb.w)};
#pragma unroll
                        for (int e = 0; e < 4; ++e) { b0[e] = fmaxf(b0[e], 1e-30f); b1[e] = fmaxf(b1[e], 1e-30f); }
                        const f32x4 r0 = acc[ai][bj][m][0] * b0, r1 = acc[ai][bj][m][1] * b1;
                        u32x4 o; o.x = cvtpk(r0[0], r0[1]); o.y = cvtpk(r0[2], r0[3]); o.z = cvtpk(r1[0], r1[1]); o.w = cvtpk(r1[2], r1[3]);
                        *(u32x4*)(Z + (size_t)(tok0 + ai * 128 + m * 16) * DM + c0 + bj * 128) = o;
                    }
            }
        }
        return u.kind == 0;
    }
};

struct EpiOut {
    const float* X; bf16_t* X1B; float* SSQ;
    __device__ __forceinline__ bool operator()(AccT& acc, const pg8::Unit& u, int wr, int wc, int fr, int fq) const {
        const int tok0 = u.pm * 256 + wr * 64 + fr, c0 = u.pn * 256 + wc * 32 + 8 * fq;
#pragma unroll
        for (int am = 0; am < 4; ++am) { const int ai = am >> 1;
            f32x4 xv[4][2][2];
#pragma unroll
            for (int m = 2 * (am & 1); m < 2 * (am & 1) + 2; ++m)
#pragma unroll
                for (int bj = 0; bj < 2; ++bj) { const float* xp = X + (size_t)(tok0 + ai * 128 + m * 16) * DM + c0 + bj * 128; xv[m][bj][0] = *(const f32x4*)xp; xv[m][bj][1] = *(const f32x4*)(xp + 4); }
#pragma unroll
            for (int m = 2 * (am & 1); m < 2 * (am & 1) + 2; ++m) {
                const int tok = tok0 + ai * 128 + m * 16; float ss = 0.f;
#pragma unroll
                for (int bj = 0; bj < 2; ++bj) {
                    const size_t off = (size_t)tok * DM + c0 + bj * 128;
                    const f32x4 r0 = acc[ai][bj][m][0] + xv[m][bj][0], r1 = acc[ai][bj][m][1] + xv[m][bj][1];
                    u32x4 o; o.x = cvtpk(r0[0], r0[1]); o.y = cvtpk(r0[2], r0[3]); o.z = cvtpk(r1[0], r1[1]); o.w = cvtpk(r1[2], r1[3]);
                    *(u32x4*)(X1B + off) = o;
#pragma unroll
                    for (int e = 0; e < 4; ++e) ss += r0[e] * r0[e] + r1[e] * r1[e];
                }
                ss += __shfl_xor(ss, 16); ss += __shfl_xor(ss, 32);
                if (fq == 0) SSQ[(size_t)(u.pn * 4 + wc) * MTOK + tok] = ss;
            }
        }
        return false;
    }
};

struct EpiFfn1 {
    bf16_t* ACT; const LAS float* rtab; int pm0, pm1, pm2, pm3;
    __device__ __forceinline__ bool operator()(AccT& acc, const pg8::Unit& u, int wr, int wc, int fr, int fq) const {
        const int tok0 = u.pm * 256 + wr * 64 + fr, c0 = u.pn * 128 + wc * 32 + 8 * fq;
        const int sl = u.pm == pm1 ? 1 : (u.pm == pm2 ? 2 : (u.pm == pm3 ? 3 : 0));
        const LAS float* rt = rtab + sl * 256 + wr * 64 + fr;
#pragma unroll
        for (int ai = 0; ai < 2; ++ai)
#pragma unroll
            for (int m = 0; m < 4; ++m) {
                const int tok = tok0 + ai * 128 + m * 16;
                const float rstd = rt[ai * 128 + m * 16];
                const f32x4 a0 = acc[ai][0][m][0] * rstd, a1 = acc[ai][0][m][1] * rstd, b0 = acc[ai][1][m][0] * rstd, b1 = acc[ai][1][m][1] * rstd;
                f32x4 r0, r1;
#pragma unroll
                for (int e = 0; e < 4; ++e) { r0[e] = a0[e] * sigmoidf_(a0[e]) * b0[e]; r1[e] = a1[e] * sigmoidf_(a1[e]) * b1[e]; }
                u32x4 o; o.x = cvtpk(r0[0], r0[1]); o.y = cvtpk(r0[2], r0[3]); o.z = cvtpk(r1[0], r1[1]); o.w = cvtpk(r1[2], r1[3]);
                *(u32x4*)(ACT + (size_t)tok * DFF + c0) = o;
            }
        return false;
    }
};

struct EpiFfn1g {
    const float* SSQ; bf16_t* ACT;
    __device__ __forceinline__ bool operator()(AccT& acc, const pg8::Unit& u, int wr, int wc, int fr, int fq) const {
        const int tok0 = u.pm * 256 + wr * 64 + fr, c0 = u.pn * 128 + wc * 32 + 8 * fq;
        float rs[2][4];
#pragma unroll
        for (int ai = 0; ai < 2; ++ai)
#pragma unroll
            for (int m = 0; m < 4; ++m) { const int tok = tok0 + ai * 128 + m * 16; float ss = 0.f;
#pragma unroll
                for (int j = 0; j < 4; ++j) ss += SSQ[(size_t)(4 * fq + j) * MTOK + tok];
                rs[ai][m] = ss; }
#pragma unroll
        for (int ai = 0; ai < 2; ++ai)
#pragma unroll
            for (int m = 0; m < 4; ++m) { float ss = rs[ai][m]; ss += __shfl_xor(ss, 16); ss += __shfl_xor(ss, 32); rs[ai][m] = __builtin_amdgcn_rsqf(ss * (1.0f / DM) + EPS); }
#pragma unroll
        for (int ai = 0; ai < 2; ++ai)
#pragma unroll
            for (int m = 0; m < 4; ++m) {
                const int tok = tok0 + ai * 128 + m * 16;
                const float rstd = rs[ai][m];
                const f32x4 a0 = acc[ai][0][m][0] * rstd, a1 = acc[ai][0][m][1] * rstd, b0 = acc[ai][1][m][0] * rstd, b1 = acc[ai][1][m][1] * rstd;
                f32x4 r0, r1;
#pragma unroll
                for (int e = 0; e < 4; ++e) { r0[e] = a0[e] * sigmoidf_(a0[e]) * b0[e]; r1[e] = a1[e] * sigmoidf_(a1[e]) * b1[e]; }
                u32x4 o; o.x = cvtpk(r0[0], r0[1]); o.y = cvtpk(r0[2], r0[3]); o.z = cvtpk(r1[0], r1[1]); o.w = cvtpk(r1[2], r1[3]);
                *(u32x4*)(ACT + (size_t)tok * DFF + c0) = o;
            }
        return false;
    }
};

struct EpiFfn2 {
    const bf16_t* X1B; float* OUT;
    __device__ __forceinline__ bool operator()(AccT& acc, const pg8::Unit& u, int wr, int wc, int fr, int fq) const {
        const int tok0 = u.pm * 256 + wr * 64 + fr, c0 = u.pn * 256 + wc * 32 + 8 * fq;
#pragma unroll
        for (int ai = 0; ai < 2; ++ai) {
            u32x4 xw[4][2];
#pragma unroll
            for (int m = 0; m < 4; ++m)
#pragma unroll
                for (int bj = 0; bj < 2; ++bj) xw[m][bj] = *(const u32x4*)(X1B + (size_t)(tok0 + ai * 128 + m * 16) * DM + c0 + bj * 128);
#pragma unroll
            for (int m = 0; m < 4; ++m) {
                const int tok = tok0 + ai * 128 + m * 16;
#pragma unroll
                for (int bj = 0; bj < 2; ++bj) {
                    const size_t off = (size_t)tok * DM + c0 + bj * 128;
                    const u32x4 w = xw[m][bj];
                    const f32x4 x0 = {bf_lo(w.x), bf_hi(w.x), bf_lo(w.y), bf_hi(w.y)}, x1 = {bf_lo(w.z), bf_hi(w.z), bf_lo(w.w), bf_hi(w.w)};
                    *(f32x4*)(OUT + off) = acc[ai][bj][m][0] + x0; *(f32x4*)(OUT + off + 4) = acc[ai][bj][m][1] + x1;
                }
            }
        }
        return false;
    }
};

struct AttnRing { u32x4 kr[4]; u32x4 vr[4]; };
__device__ __forceinline__ void att_load(AttnRing& R, const bf16_t* K, const bf16_t* V, int voff, int kt, int klo, int khi) {
    const int kc = kt < klo ? klo : (kt > khi ? khi : kt);
    const bf16_t* kp = K + (voff + kc * 32 * HD); const bf16_t* vp = V + (voff + kc * 32 * HD);
#pragma unroll
    for (int i = 0; i < 4; ++i) R.kr[i] = *(const u32x4*)(kp + i * 8 * HD);
#pragma unroll
    for (int i = 0; i < 4; ++i) R.vr[i] = *(const u32x4*)(vp + i * 8 * HD);
}
template <int KT>
__device__ __forceinline__ void att_step(const AttnRing& R, const bf16x8 (&qf)[4], int klo, int khi, LAS unsigned char* vst, int vwr, int trb0, int trb1,
                                         LAS unsigned char* kst, int kw0, int kw1, int krd, int kf_, int r32, int hi, f32x16 (&o)[2], float& lsum) {
    if (KT >= klo && KT <= khi) {
#pragma unroll
        for (int i = 0; i < 4; ++i) *(LAS u32x4*)(kst + ((i & 1) ? kw1 : kw0) + i * 1024) = R.kr[i];
#pragma unroll
        for (int i = 0; i < 4; ++i) *(LAS u32x4*)(vst + vwr + i * 1024) = R.vr[i];
        bf16x8 kf[4];
#pragma unroll
        for (int s = 0; s < 4; ++s) kf[s] = *(const LAS bf16x8*)(kst + krd + (((2 * s + hi) ^ kf_) << 4));
        f32x16 p = {0.f, 0.f, 0.f, 0.f, 0.f, 0.f, 0.f, 0.f, 0.f, 0.f, 0.f, 0.f, 0.f, 0.f, 0.f, 0.f};
#pragma unroll
        for (int s = 0; s < 4; ++s) p = __builtin_amdgcn_mfma_f32_32x32x16_bf16(kf[s], qf[s], p, 0, 0, 0);
#pragma unroll
        for (int r = 0; r < 16; ++r) { const int kk = (r & 3) + 8 * (r >> 2) + 4 * hi; float e = __builtin_amdgcn_exp2f(p[r]);
            if (KT == 0) e = (kk >= r32) ? e : 0.f;
            if (KT == 4) e = (kk <= r32) ? e : 0.f;
            p[r] = e; }
        lsum += ((p[0] + p[1]) + (p[2] + p[3])) + ((p[4] + p[5]) + (p[6] + p[7])) + (((p[8] + p[9]) + (p[10] + p[11])) + ((p[12] + p[13]) + (p[14] + p[15])));
        bf16x8 pb[2];
#pragma unroll
        for (int s = 0; s < 2; ++s) { u32x4 w; w.x = cvtpk(p[8 * s], p[8 * s + 1]); w.y = cvtpk(p[8 * s + 2], p[8 * s + 3]); w.z = cvtpk(p[8 * s + 4], p[8 * s + 5]); w.w = cvtpk(p[8 * s + 6], p[8 * s + 7]); pb[s] = __builtin_bit_cast(bf16x8, w); }
#pragma unroll
        for (int dt = 0; dt < 2; ++dt)
#pragma unroll
            for (int s = 0; s < 2; ++s) {
                const int tb = dt ? trb1 : trb0;
                const s16x4 lo = __builtin_bit_cast(s16x4, __builtin_amdgcn_ds_read_tr16_b64_v4i16((LAS s16x4*)(vst + tb + s * 2048)));
                const s16x4 hh = __builtin_bit_cast(s16x4, __builtin_amdgcn_ds_read_tr16_b64_v4i16((LAS s16x4*)(vst + tb + s * 2048 + 1024)));
                const bf16x8 vf = {lo[0], lo[1], lo[2], lo[3], hh[0], hh[1], hh[2], hh[3]};
                o[dt] = __builtin_amdgcn_mfma_f32_32x32x16_bf16(vf, pb[s], o[dt], 0, 0, 0);
            }
        LDS_WAIT();
    }
}
__device__ __forceinline__ int acc_row(int t) { return (t & 0xF0) | ((t + (t >> 4)) & 15); }
__device__ __forceinline__ void attn_merge(LAS float* accO, LAS float* accL, const f32x16 (&o)[2], float l, int tk, int hi, bool first) {
    if (tk >= 0) {
        const int row = acc_row(tk);
#pragma unroll
        for (int dt = 0; dt < 2; ++dt)
#pragma unroll
            for (int rg = 0; rg < 4; ++rg) {
                LAS f32x4* p = (LAS f32x4*)(accO + row * 68 + 32 * dt + 8 * rg + 4 * hi);
                f32x4 v = {o[dt][4 * rg], o[dt][4 * rg + 1], o[dt][4 * rg + 2], o[dt][4 * rg + 3]};
                if (!first) v = v + *p;
                *p = v;
            }
        if (hi == 0) { if (!first) l += accL[tk]; accL[tk] = l; }
    }
}
__device__ __forceinline__ void attn_finalize(const LAS float* accO, const LAS float* accL, bf16_t* AU, int b, int h, int chunk, int tid) {
    const int tk = tid >> 1, half = tid & 1;
    const float rl = 1.0f / accL[tk];
    const LAS f32x4* p = (const LAS f32x4*)(accO + acc_row(tk) * 68 + 32 * half);
    bf16_t* dst = AU + (size_t)(b * SEQ + 256 * chunk + tk) * DM + h * HD + 32 * half;
#pragma unroll
    for (int i = 0; i < 4; ++i) { const f32x4 a = p[2 * i] * rl, bb = p[2 * i + 1] * rl;
        u32x4 ov; ov.x = cvtpk(a[0], a[1]); ov.y = cvtpk(a[2], a[3]); ov.z = cvtpk(bb[0], bb[1]); ov.w = cvtpk(bb[2], bb[3]);
        *(u32x4*)(dst + 8 * i) = ov; }
}
struct AttnTile { size_t seq0; int Lg, q0; };
__device__ __forceinline__ AttnTile attn_desc(int j, int b, int h, int sc, int w) {
    AttnTile t;
    if (j < 2) { t.seq0 = (size_t)((b * NGRP + 2) * NHEAD + h) * SEQ + (size_t)(2 * w + j) * 128; t.Lg = 128; t.q0 = 32 * sc; }
    else { const int c = 2 * sc + ((j - 2) >> 1);
        if ((j & 1) == 0) { t.seq0 = (size_t)((b * NGRP + 0) * NHEAD + h) * SEQ; t.Lg = 2048; t.q0 = 256 * c + 32 * w; }
        else { t.seq0 = (size_t)((b * NGRP + 1) * NHEAD + h) * SEQ + (size_t)(w >> 1) * 512; t.Lg = 512; t.q0 = 64 * c + 32 * (w & 1); } }
    return t;
}
__device__ __forceinline__ void attn_super(const bf16_t* Q, const bf16_t* K, const bf16_t* V, bf16_t* AU, float negc, LAS unsigned char* scr, int item) {
    int tid = threadIdx.x; asm volatile("" : "+v"(tid));
    const int lane = tid & 63, w = __builtin_amdgcn_readfirstlane(tid >> 6), r32 = lane & 31, hi = lane >> 5;
    const int sc = item & 3, h = (item >> 2) & 7, b = item >> 5;
    LAS float* accO = (LAS float*)scr;
    LAS float* accL = (LAS float*)(scr + 256 * 68 * 4);
    LAS unsigned char* vst = scr + 256 * 68 * 4 + 1024 + w * 4096;
    const int vwr = (lane >> 3) * 128 + (((lane & 7) * 16) ^ (((lane >> 4) & 1) << 6));
    const int qsw = ((lane & 15) >> 3) & 1;
    const int trrow = (4 * hi + ((lane & 15) >> 2)) * 128 + ((lane >> 4) & 1) * 32 + (lane & 3) * 8;
    const int trb0 = trrow + 64 * qsw, trb1 = trrow + 64 * (1 - qsw);
    LAS unsigned char* kst = scr + 256 * 68 * 4 + 1024 + 32768 + w * 4096;
    const int kw0 = (lane >> 3) * 128 + (((lane & 7) ^ (lane >> 4)) << 4), kw1 = (lane >> 3) * 128 + (((lane & 7) ^ ((lane >> 4) + 4)) << 4);
    const int krd = r32 * 128, kf_ = (r32 >> 1) & 7;
    AttnRing R0, R1, R2;
    f32x16 og2[2]; float lg2 = 0.f;
    AttnTile cur = attn_desc(0, b, h, sc, w);
    int klo = cur.q0 >= 64 ? 0 : 2 - (cur.q0 >> 5), khi = ((cur.Lg - cur.q0 + 32) >> 5) > 4 ? 4 : ((cur.Lg - cur.q0 + 32) >> 5);
    int voff = ((int)cur.seq0 + cur.q0 - 64 + (lane >> 3)) * HD + (lane & 7) * 8;
    bf16x8 qf[4];
    att_load(R0, K, V, voff, 0, klo, khi); att_load(R1, K, V, voff, 1, klo, khi);
    { const bf16_t* qp = Q + (cur.seq0 + cur.q0 + r32) * HD + 8 * hi;
#pragma unroll
      for (int s = 0; s < 4; ++s) qf[s] = *(const bf16x8*)(qp + 16 * s); }
#pragma unroll 1
    for (int j = 0; j < 6; ++j) {
        f32x16 o[2]; float ls = 0.f;
#pragma unroll
        for (int r = 0; r < 16; ++r) { o[0][r] = 0.f; o[1][r] = 0.f; }
        att_load(R2, K, V, voff, 2, klo, khi);
        att_step<0>(R0, qf, klo, khi, vst, vwr, trb0, trb1, kst, kw0, kw1, krd, kf_, r32, hi, o, ls);
        att_load(R0, K, V, voff, 3, klo, khi);
        att_step<1>(R1, qf, klo, khi, vst, vwr, trb0, trb1, kst, kw0, kw1, krd, kf_, r32, hi, o, ls);
        att_load(R1, K, V, voff, 4, klo, khi);
        att_step<2>(R2, qf, klo, khi, vst, vwr, trb0, trb1, kst, kw0, kw1, krd, kf_, r32, hi, o, ls);
        const AttnTile nxt = attn_desc(j < 5 ? j + 1 : 5, b, h, sc, w);
        const int nklo = nxt.q0 >= 64 ? 0 : 2 - (nxt.q0 >> 5), nkhi = ((nxt.Lg - nxt.q0 + 32) >> 5) > 4 ? 4 : ((nxt.Lg - nxt.q0 + 32) >> 5);
        const int nvoff = ((int)nxt.seq0 + nxt.q0 - 64 + (lane >> 3)) * HD + (lane & 7) * 8;
        att_step<3>(R0, qf, klo, khi, vst, vwr, trb0, trb1, kst, kw0, kw1, krd, kf_, r32, hi, o, ls);
        att_load(R0, K, V, nvoff, 0, nklo, nkhi);
        att_step<4>(R1, qf, klo, khi, vst, vwr, trb0, trb1, kst, kw0, kw1, krd, kf_, r32, hi, o, ls);
        { att_load(R1, K, V, nvoff, 1, nklo, nkhi);
            const bf16_t* qp = Q + (nxt.seq0 + nxt.q0 + r32) * HD + 8 * hi;
#pragma unroll
            for (int s = 0; s < 4; ++s) qf[s] = *(const bf16x8*)(qp + 16 * s); }
        const float l = ls + __shfl_xor(ls, 32);
        int tq = threadIdx.x; asm volatile("" : "+v"(tq));
        const int r32m = tq & 31, him = (tq >> 5) & 1;
        if (j < 2) {
            attn_merge(accO, accL, o, l, r32m < 16 ? 16 * r32m + 2 * w + j : -1, him, true);
            if (j == 0) { og2[0] = o[0]; og2[1] = o[1]; lg2 = l; }
            else {
#pragma unroll
                for (int r = 0; r < 16; ++r) { const float m0 = __shfl_xor(o[0][r], 16), m1 = __shfl_xor(o[1][r], 16); if (r32m < 16) { og2[0][r] = m0; og2[1][r] = m1; } }
                const float ml = __shfl_xor(l, 16); if (r32m < 16) lg2 = ml;
            }
        } else if ((j & 1) == 0) {
            __syncthreads();
            attn_merge(accO, accL, o, l, 32 * w + r32m, him, false);
        } else {
            __syncthreads();
            attn_merge(accO, accL, o, l, 4 * (32 * (w & 1) + r32m) + (w >> 1), him, false);
            __syncthreads();
            attn_finalize(accO, accL, AU, b, h, 2 * sc + ((j - 3) >> 1), tq);
            __syncthreads();
            if (j == 3) attn_merge(accO, accL, og2, lg2, r32m >= 16 ? 16 * (r32m - 16) + 2 * w : 16 * r32m + 2 * w + 1, him, true);
        }
        cur = nxt; klo = nklo; khi = nkhi; voff = nvoff;
    }
}

__device__ __forceinline__ void conv_unit(const bf16_t* U, const float* cw, const float* cb, const float* lnw, const float* lnb, bf16_t* AU, LAS unsigned char* scr, int unit) {
    int tid = threadIdx.x; asm volatile("" : "+v"(tid));
    const int lane = tid & 63, w = tid >> 6;
    const int b = unit >> 5, s0 = (unit & 31) * 64;
    const int cp = tid & 255, tg = tid >> 8;
    LAS float* cbuf = (LAS float*)scr;
    unsigned win[62];
#pragma unroll
    for (int i = 0; i < 62; ++i) { const int s = s0 + 32 * tg - 15 + i; win[i] = (s >= 0 && s < SEQ) ? *(const unsigned*)(U + (size_t)(b * SEQ + s) * CCH + 2 * cp) : 0u; }
    f32x2 acc[32];
    const f32x2 bias = *(const f32x2*)(cb + 2 * cp);
#pragma unroll
    for (int k = 0; k < 32; ++k) acc[k] = bias;
#pragma unroll
    for (int j = 0; j < CW; ++j) {
        const f32x2 wj = *(const f32x2*)(cw + j * CCH + 2 * cp);
#pragma unroll
        for (int k = 0; k < 32; ++k) { acc[k].x += wj.x * bf_lo(win[k + j]); acc[k].y += wj.y * bf_hi(win[k + j]); }
    }
#pragma unroll
    for (int k = 0; k < 32; ++k) *(LAS f32x2*)(cbuf + (32 * tg + k) * 516 + 2 * cp) = acc[k];
    __syncthreads();
    const f32x4 g0 = *(const f32x4*)(lnw + 4 * lane), g1 = *(const f32x4*)(lnw + 256 + 4 * lane), e0 = *(const f32x4*)(lnb + 4 * lane), e1 = *(const f32x4*)(lnb + 256 + 4 * lane);
    f32x4 va[8], vc[8]; float sm[8], sq[8];
#pragma unroll
    for (int k = 0; k < 8; ++k) { const int t = 8 * w + k;
        va[k] = *(const LAS f32x4*)(cbuf + t * 516 + 4 * lane); vc[k] = *(const LAS f32x4*)(cbuf + t * 516 + 256 + 4 * lane);
        sm[k] = (va[k][0] + va[k][1]) + (va[k][2] + va[k][3]) + (vc[k][0] + vc[k][1]) + (vc[k][2] + vc[k][3]); }
#pragma unroll
    for (int o = 1; o < 64; o <<= 1)
#pragma unroll
        for (int k = 0; k < 8; ++k) sm[k] += __shfl_xor(sm[k], o);
#pragma unroll
    for (int k = 0; k < 8; ++k) { const float mean = sm[k] * (1.0f / CCH); va[k] = va[k] - mean; vc[k] = vc[k] - mean;
        sq[k] = (va[k][0] * va[k][0] + va[k][1] * va[k][1]) + (va[k][2] * va[k][2] + va[k][3] * va[k][3]) + (vc[k][0] * vc[k][0] + vc[k][1] * vc[k][1]) + (vc[k][2] * vc[k][2] + vc[k][3] * vc[k][3]); }
#pragma unroll
    for (int o = 1; o < 64; o <<= 1)
#pragma unroll
        for (int k = 0; k < 8; ++k) sq[k] += __shfl_xor(sq[k], o);
#pragma unroll
    for (int k = 0; k < 8; ++k) {
        const int t = 8 * w + k;
        const float rstd = __builtin_amdgcn_rsqf(sq[k] * (1.0f / CCH) + EPS);
        f32x4 a = va[k] * rstd * g0 + e0, c = vc[k] * rstd * g1 + e1;
#pragma unroll
        for (int e = 0; e < 4; ++e) { a[e] = a[e] * sigmoidf_(a[e]); c[e] = c[e] * sigmoidf_(c[e]); }
        bf16_t* dst = AU + (size_t)(b * SEQ + s0 + t) * DM + CCH;
        u32x2 oa, oc; oa.x = cvtpk(a[0], a[1]); oa.y = cvtpk(a[2], a[3]); oc.x = cvtpk(c[0], c[1]); oc.y = cvtpk(c[2], c[3]);
        *(u32x2*)(dst + 4 * lane) = oa; *(u32x2*)(dst + 256 + 4 * lane) = oc;
    }
    __syncthreads();
}

__device__ __forceinline__ void p0_load(const float* W, int N, int k0, int cbase, const float* kscale, f32x4 (&v)[8], int lane) {
#pragma unroll
    for (int i = 0; i < 8; ++i) { const int kk = 8 * i + (lane >> 3); v[i] = *(const f32x4*)(W + (size_t)(k0 + kk) * N + cbase + 4 * (lane & 7)); if (kscale) v[i] = v[i] * kscale[k0 + kk]; }
}
__device__ __forceinline__ void p0_store(const f32x4 (&v)[8], int k0, bool qkperm, bf16_t* WT, int ldo, int kdst, int rho0, LAS float* scr, int lane) {
#pragma unroll
    for (int i = 0; i < 8; ++i) { LAS float* d = scr + (8 * i + (lane >> 3)) * 33 + 4 * (lane & 7); d[0] = v[i][0]; d[1] = v[i][1]; d[2] = v[i][2]; d[3] = v[i][3]; }
    LDS_WAIT(); asm volatile("" ::: "memory");
    const int c = lane & 7;
#pragma unroll
    for (int j = 0; j < 4; ++j) {
        const int n = (lane >> 3) + 8 * j;
        int src = perm32(n); if (qkperm) src = pos2dim(src);
        const LAS float* sp = scr + (8 * c) * 33 + src;
        u32x4 o; o.x = cvtpk(sp[0 * 33], sp[1 * 33]); o.y = cvtpk(sp[2 * 33], sp[3 * 33]); o.z = cvtpk(sp[4 * 33], sp[5 * 33]); o.w = cvtpk(sp[6 * 33], sp[7 * 33]);
        *(u32x4*)(WT + (size_t)(rho0 + n) * ldo + kdst + k0 + 8 * c) = o;
    }
    LDS_WAIT(); asm volatile("" ::: "memory");
}

struct Params {
    const float* x; const int* pos; const float *norm1_w, *w_in, *b_gate, *q_norm_w, *k_norm_w, *w_o_attn, *conv_w, *conv_b, *conv_ln_w, *conv_ln_b, *w_pw_conv, *w_out, *norm2_w, *w_ffn_in, *w_ffn_out;
    float* out; unsigned char* ws;
};

__constant__ double c_invfreq[8] = {1.0, 0.19392274474868576, 0.03760603093086393, 0.007292664737217109, 0.001414213562373095, 0.0002742481756762073, 5.318295896944988e-05, 1.031338537721246e-05};

constexpr int I_IN = 16 * (NIN / 32), I_O = 8 * 32, I_PW = 8 * 32, I_OUT = 16 * 32, I_F1 = 16 * (NF1 / 32), I_F2 = (DFF / 64) * 32;
constexpr int P0_NITEMS = I_IN + I_O + I_PW + I_OUT + I_F1 + I_F2;
template <bool LOAD>
__device__ __forceinline__ void p0_item(const Params& P, int it, f32x4 (&v)[8], LAS float* scr, int lane) {
    unsigned char* ws = P.ws;
    int r = it;
    if (r < I_IN) {
        const int kb = r / (NIN / 32), gi = r % (NIN / 32), rho0 = gi * 32;
        const int pn = rho0 >> 8, bj = (rho0 >> 7) & 1, wc = (rho0 >> 5) & 3;
        int cbase; bool qk = false;
        if (pn < 18) { const int sec = pn / 6, pt = pn - sec * 6, g = pt >> 1, head = 4 * (pt & 1) + wc; cbase = sec * QKVW + g * 512 + head * 64 + 32 * bj; qk = (sec < 2) && (bj == 0); }
        else if (pn < 22) cbase = 3 * QKVW + 512 * bj + (pn - 18) * 128 + 32 * wc;
        else cbase = 3 * QKVW + 1024 + (pn - 22) * 256 + 128 * bj + 32 * wc;
        if (LOAD) p0_load(P.w_in, NIN, kb * 64, cbase, nullptr, v, lane); else p0_store(v, kb * 64, qk, (bf16_t*)(ws + WS_WIN), DM, 0, rho0, scr, lane);
        return; }
    r -= I_IN;
    if (r < I_O) { const int kb = r / 32, gi = r % 32; if (LOAD) p0_load(P.w_o_attn, DM, kb * 64, gi * 32, nullptr, v, lane); else p0_store(v, kb * 64, false, (bf16_t*)(ws + WS_WCAT), DM, 0, gi * 32, scr, lane); return; }
    r -= I_O;
    if (r < I_PW) { const int kb = r / 32, gi = r % 32; if (LOAD) p0_load(P.w_pw_conv, DM, kb * 64, gi * 32, nullptr, v, lane); else p0_store(v, kb * 64, false, (bf16_t*)(ws + WS_WCAT), DM, 512, gi * 32, scr, lane); return; }
    r -= I_PW;
    if (r < I_OUT) { const int kb = r / 32, gi = r % 32; if (LOAD) p0_load(P.w_out, DM, kb * 64, gi * 32, nullptr, v, lane); else p0_store(v, kb * 64, false, (bf16_t*)(ws + WS_WOUT), DM, 0, gi * 32, scr, lane); return; }
    r -= I_OUT;
    if (r < I_F1) {
        const int kb = r / (NF1 / 32), gi = r % (NF1 / 32), rho0 = gi * 32;
        const int pn = rho0 >> 8, bj = (rho0 >> 7) & 1, wc = (rho0 >> 5) & 3;
        if (LOAD) p0_load(P.w_ffn_in, NF1, kb * 64, DFF * bj + 128 * pn + 32 * wc, P.norm2_w, v, lane); else p0_store(v, kb * 64, false, (bf16_t*)(ws + WS_WF1), DM, 0, rho0, scr, lane);
        return; }
    r -= I_F1;
    { const int kb = r / 32, gi = r % 32; if (LOAD) p0_load(P.w_ffn_out, DM, kb * 64, gi * 32, nullptr, v, lane); else p0_store(v, kb * 64, false, (bf16_t*)(ws + WS_WF2), DFF, 0, gi * 32, scr, lane); }
}

__device__ __forceinline__ void p0_weights(const Params& P, LAS float* scr, int lane, int iw, int nw, int lo, int hi) {
    f32x4 va[8], vb[8];
    int it = lo + iw;
    if (it < hi) p0_item<true>(P, it, va, scr, lane);
    while (it < hi) {
        const int nx = it + nw;
        if (nx < hi) p0_item<true>(P, nx, vb, scr, lane);
        p0_item<false>(P, it, va, scr, lane);
        it = nx;
        if (it >= hi) break;
        const int nx2 = it + nw;
        if (nx2 < hi) p0_item<true>(P, nx2, va, scr, lane);
        p0_item<false>(P, it, vb, scr, lane);
        it = nx2;
    }
}
__device__ __forceinline__ void p0_prologue(const Params& P, LAS unsigned char* scrb, int vcu, int G) {
    int tid = threadIdx.x; asm volatile("" : "+v"(tid));
    const int lane = tid & 63, wave = tid >> 6;
    LAS float* scr = (LAS float*)(scrb + wave * 16384);
    const int gw = vcu * 8 + wave, NGW = G * 8;
    unsigned char* ws = P.ws;
    bf16_t* Hn = (bf16_t*)((unsigned char*)P.out + DO_H);
    { f32x4 nw[4];
#pragma unroll
      for (int j = 0; j < 4; ++j) nw[j] = *((const f32x4*)P.norm1_w + lane + 64 * j);
      for (int m0 = gw; m0 < MTOK; m0 += 4 * NGW) {
        f32x4 v[4][4];
#pragma unroll
        for (int q = 0; q < 4; ++q) { const int m = m0 + q * NGW; if (m < MTOK) { const f32x4* xr = (const f32x4*)(P.x + (size_t)m * DM) + lane;
#pragma unroll
            for (int j = 0; j < 4; ++j) v[q][j] = xr[64 * j]; } }
#pragma unroll
        for (int q = 0; q < 4; ++q) { const int m = m0 + q * NGW; if (m < MTOK) {
            float s = 0.f;
#pragma unroll
            for (int j = 0; j < 4; ++j) s += (v[q][j][0] * v[q][j][0] + v[q][j][1] * v[q][j][1]) + (v[q][j][2] * v[q][j][2] + v[q][j][3] * v[q][j][3]);
            const float rstd = __builtin_amdgcn_rsqf(wave_sum(s) * (1.0f / DM) + EPS);
            u32x2* o8 = (u32x2*)(Hn + (size_t)m * DM) + lane;
#pragma unroll
            for (int j = 0; j < 4; ++j) { const f32x4 y = v[q][j] * rstd * nw[j]; u32x2 o; o.x = cvtpk(y[0], y[1]); o.y = cvtpk(y[2], y[3]); o8[64 * j] = o; } } }
      } }
    p0_weights(P, scr, lane, gw, NGW, 0, I_IN);
    float* rope = (float*)(ws + WS_ROPE);
    for (int i = vcu * 512 + tid; i < MTOK * 8; i += G * 512) {
        const int tok = i >> 3, f = i & 7;
        const double ang = (double)P.pos[tok] * c_invfreq[f];
        const double kq = __builtin_rint(ang * 0.15915494309189535);
        const double xr = __builtin_fma(-kq, 6.283185307179586, ang) - kq * 2.4492935982947064e-16;
        const double x2 = xr * xr;
        double sn = 1.0, cs = 1.0;
#pragma unroll
        for (int n = 12; n >= 1; --n) { sn = 1.0 - sn * x2 / (double)((2 * n) * (2 * n + 1)); cs = 1.0 - cs * x2 / (double)((2 * n - 1) * (2 * n)); }
        sn *= xr;
        rope[(size_t)tok * 16 + f] = (float)cs; rope[(size_t)tok * 16 + 8 + f] = (float)sn;
    }
}

#define RLX_AGENT __ATOMIC_RELAXED, __HIP_MEMORY_SCOPE_AGENT
#define XB_TMO      128
#define XB_XCNT(j)  (256  + 64 * (j))
#define XB_XSUB(j)  (1280 + 64 * (j))
#define XB_XGEN(j)  (2304 + 64 * (j))
#define XB_TOP      3328
#define XB_TOPGEN   3392
#define XCD_BAR_WORDS 3456
#define XB_SPIN_CAP (1u << 18)
__device__ __forceinline__ unsigned xb_ld(unsigned* p)              { return __hip_atomic_load(p, __ATOMIC_RELAXED, __HIP_MEMORY_SCOPE_AGENT); }
__device__ __forceinline__ unsigned xb_add(unsigned* p, unsigned v) { return __hip_atomic_fetch_add(p, v, __ATOMIC_RELAXED, __HIP_MEMORY_SCOPE_AGENT); }
__device__ __forceinline__ unsigned xb_xcc_id() { return (unsigned)__builtin_amdgcn_s_getreg((3 << 11) | 20) & 0xFu; }
#define XB_SPIN(cond, bar) do { unsigned _sp = 0; while (cond) { __builtin_amdgcn_s_sleep(1); \
    if ((++_sp & 255u) == 0u) { if (xb_ld(&(bar)[XB_TMO])) break; if (_sp > XB_SPIN_CAP) { atomicAdd(&(bar)[XB_TMO], 1u); break; } } } } while (0)
struct XcdBarrier { unsigned* bar; unsigned x; volatile LAS unsigned* st; };
__device__ __forceinline__ XcdBarrier xcd_barrier_post(unsigned* bar, volatile LAS unsigned* st) {
    XcdBarrier b; b.bar = bar; b.x = xb_xcc_id(); b.st = st;
    if (threadIdx.x == 0) (void)xb_add(&bar[XB_XCNT(b.x)], 1u);
    return b;
}
__device__ __forceinline__ void xcd_barrier_complete(unsigned* bar, unsigned x, unsigned& nloc, unsigned& nx) {
    const unsigned G = gridDim.x * gridDim.y * gridDim.z;
    unsigned sum, cnt, mine, sp = 0u;
    for (;;) {
        sum = 0u; cnt = 0u; mine = 0u;
#pragma unroll
        for (unsigned j = 0; j < 16; ++j) { const unsigned c = xb_ld(&bar[XB_XCNT(j)]); sum += c; cnt += (c > 0u) ? 1u : 0u; mine = (j == x) ? c : mine; }
        if (sum == G) break;
        __builtin_amdgcn_s_sleep(1);
        if ((++sp & 255u) == 0u) { if (xb_ld(&bar[XB_TMO])) break; if (sp > XB_SPIN_CAP) { atomicAdd(&bar[XB_TMO], 1u); break; } }
    }
    nloc = mine > 0u ? mine : 1u; nx = cnt > 0u ? cnt : 1u;
}
__device__ __forceinline__ void xcd_barrier(const XcdBarrier& b) {
    asm volatile("s_waitcnt vmcnt(0)" ::: "memory");
    __syncthreads();
    if (threadIdx.x == 0) {
        unsigned* bar = b.bar;
        __builtin_amdgcn_s_waitcnt(0);
        unsigned nloc = b.st[0], nx = b.st[1];
        if (nloc == 0u) { xcd_barrier_complete(bar, b.x, nloc, nx); b.st[0] = nloc; b.st[1] = nx; }
        const unsigned old = xb_add(&bar[XB_XSUB(b.x)], 1u);
        const unsigned gen = old / nloc;
        if (old + 1u == (gen + 1u) * nloc) {
            __builtin_amdgcn_fence(__ATOMIC_RELEASE, "agent");
            asm volatile("s_waitcnt vmcnt(0)" ::: "memory");
            const unsigned og = xb_add(&bar[XB_TOP], 1u);
            const unsigned tg = og / nx;
            if (og + 1u == (tg + 1u) * nx) xb_add(&bar[XB_TOPGEN], 1u);
            else XB_SPIN(xb_ld(&bar[XB_TOPGEN]) == tg, bar);
            __builtin_amdgcn_fence(__ATOMIC_ACQUIRE, "agent");
            xb_add(&bar[XB_XGEN(b.x)], 1u);
            asm volatile("s_waitcnt vmcnt(0)" ::: "memory");
        } else {
            XB_SPIN(xb_ld(&bar[XB_XGEN(b.x)]) == gen, bar);
            __builtin_amdgcn_fence(__ATOMIC_ACQUIRE, "agent");
            asm volatile("s_waitcnt vmcnt(0)" ::: "memory");
        }
    }
    __syncthreads();
}

#ifndef REP_P0
#define REP_P0 1
#endif
#ifndef REP_P1
#define REP_P1 1
#endif
#ifndef REP_P2A
#define REP_P2A 1
#endif
#ifndef REP_P2C
#define REP_P2C 1
#endif
#ifndef REP_P3A
#define REP_P3A 1
#endif
#ifndef REP_P3B
#define REP_P3B 1
#endif
#ifndef REP_P3C
#define REP_P3C 1
#endif
#ifndef REP_P3D
#define REP_P3D 1
#endif
#ifndef PROBE_SPIN
#define PROBE_SPIN 0
#endif
#ifndef EXTRA_SYNC
#define EXTRA_SYNC 0
#endif
__global__ void __launch_bounds__(512, 2) fwd_kernel(Params P) {
    extern __shared__ __attribute__((aligned(16))) unsigned char lds_raw[];
    LAS unsigned char* lds = (LAS unsigned char*)lds_raw;
    LAS unsigned char* scr = lds + LDS_SCR;
    const int G = gridDim.x, bx = blockIdx.x;
    const int vcu = (G % 8 == 0) ? (bx % 8) * (G / 8) + bx / 8 : bx;
    unsigned char* ws = P.ws; unsigned char* ob = (unsigned char*)P.out;
    bf16_t* Qb = (bf16_t*)(ws + WS_Q); bf16_t* Kb = (bf16_t*)(ws + WS_K); bf16_t* Vb = (bf16_t*)(ws + WS_V); bf16_t* Gt = (bf16_t*)(ws + WS_GATE);
    bf16_t* Ub = (bf16_t*)(ob + DO_U); bf16_t* AU = (bf16_t*)(ob + DO_AU); bf16_t* Hn = (bf16_t*)(ob + DO_H);
    float* SSQ = (float*)(ws + WS_SSQ);

    if (threadIdx.x < 64) ((LAS unsigned*)(lds + LDS_MISC))[threadIdx.x] = 0u;
    __syncthreads();
    const XcdBarrier xbar = xcd_barrier_post((unsigned*)(ws + WS_CTL) + 4096, (volatile LAS unsigned*)(lds + LDS_MISC) + 8);
    unsigned long long tprev = PROBE_SPIN ? __builtin_amdgcn_s_memrealtime() : 0ull;
#define SEAM(k, dosync) do { if (dosync) xcd_barrier(xbar); if (PROBE_SPIN) { const unsigned long long now_ = __builtin_amdgcn_s_memrealtime(); \
        if (PROBE_SPIN == (k)) { const unsigned long long d_ = now_ - tprev; while (__builtin_amdgcn_s_memrealtime() - now_ < d_) __builtin_amdgcn_s_sleep(8); } \
        tprev = __builtin_amdgcn_s_memrealtime(); } } while (0)
    for (int rep = 0; rep < REP_P0; ++rep) p0_prologue(P, scr, vcu, G);
    for (int rep = 0; rep < EXTRA_SYNC; ++rep) xcd_barrier(xbar);
    SEAM(1, 1);

    { pg8::Gemm g{Hn, (const bf16_t*)(ws + WS_WIN), DM, DM, DM, 0}; pg8::StaticOrder S; S.init(MTOK, NIN, G, bx);
      EpiIn E{Qb, Kb, Vb, Ub, Gt, P.q_norm_w, P.k_norm_w, P.b_gate, (const float*)(ws + WS_ROPE)};
      for (int rep = 0; rep < REP_P1; ++rep) pg8::gemm_phase(scr, g, S, E);
      const int nun = (MTOK / 256) * (NIN / 256), rem = nun % G, nidle = rem ? G - rem : G, iw = rem ? bx - rem : bx;
      if (iw >= 0) { int tid = threadIdx.x; asm volatile("" : "+v"(tid));
          p0_weights(P, (LAS float*)(scr + (tid >> 6) * 16384), tid & 63, iw * 8 + (tid >> 6), nidle * 8, I_IN, P0_NITEMS); } }
    SEAM(2, 1);

    { float qm = 0.f, km = 0.f;
      for (int i = 0; i < HD; ++i) { qm = fmaxf(qm, fabsf(P.q_norm_w[i])); km = fmaxf(km, fabsf(P.k_norm_w[i])); }
      const float negc = -fminf(8.0f * qm * km * LOG2E, 60.0f);
      for (int rep = 0; rep < REP_P2A; ++rep) for (int it = vcu; it < BATCH * NHEAD * 4; it += G) attn_super(Qb, Kb, Vb, AU, negc, scr, it);
      for (int rep = 0; rep < REP_P2C; ++rep) for (int un = vcu; un < BATCH * 32; un += G) conv_unit(Ub, P.conv_w, P.conv_b, P.conv_ln_w, P.conv_ln_b, AU, scr, un); }
    SEAM(3, 1);

    { pg8::Gemm g{AU, (const bf16_t*)(ws + WS_WCAT), DM, DM, 512, 512}; pg8::StaticOrder S; S.init(MTOK, DM, G, bx, 2);
      EpiMix E{Gt, (bf16_t*)(ws + WS_Z)};
      for (int rep = 0; rep < REP_P3A; ++rep) pg8::gemm_phase(scr, g, S, E); }
    SEAM(4, 1);

    { pg8::Gemm g{(const bf16_t*)(ws + WS_Z), (const bf16_t*)(ws + WS_WOUT), DM, DM, DM, 0}; pg8::StaticOrder S; S.init(MTOK, DM, G, bx);
      EpiOut E{P.x, (bf16_t*)(ws + WS_X1B), SSQ};
      for (int rep = 0; rep < REP_P3B; ++rep) pg8::gemm_phase(scr, g, S, E); }
    SEAM(5, 1);

    { pg8::Gemm g{(const bf16_t*)(ws + WS_X1B), (const bf16_t*)(ws + WS_WF1), DM, DM, DM, 0}; pg8::StaticOrder S; S.init(MTOK, NF1, G, bx);
      int pml[4] = {-1, -1, -1, -1}, npm = 0; bool fits = true;
      { pg8::Unit u; for (int i = 0; S.next(i, u); ++i) { if (u.pm != pml[0] && u.pm != pml[1] && u.pm != pml[2] && u.pm != pml[3]) { if (npm < 4) { if (npm == 0) pml[0] = u.pm; else if (npm == 1) pml[1] = u.pm; else if (npm == 2) pml[2] = u.pm; else pml[3] = u.pm; ++npm; } else fits = false; } } }
      LAS float* rtab = (LAS float*)(scr + 131072);
      if (fits) {
          for (int idx = threadIdx.x; idx < npm * 256; idx += 512) { const int p = idx >> 8, pmv = p == 0 ? pml[0] : (p == 1 ? pml[1] : (p == 2 ? pml[2] : pml[3])), tok = pmv * 256 + (idx & 255);
              float ss = 0.f;
#pragma unroll
              for (int j = 0; j < 16; ++j) ss += SSQ[(size_t)j * MTOK + tok];
              rtab[idx] = __builtin_amdgcn_rsqf(ss * (1.0f / DM) + EPS); }
          __syncthreads();
          EpiFfn1 E{(bf16_t*)(ws + WS_ACT), rtab, pml[0], pml[1], pml[2], pml[3]};
          for (int rep = 0; rep < REP_P3C; ++rep) pg8::gemm_phase(scr, g, S, E);
      } else {
          EpiFfn1g E{SSQ, (bf16_t*)(ws + WS_ACT)};
          for (int rep = 0; rep < REP_P3C; ++rep) pg8::gemm_phase(scr, g, S, E);
      } }
    SEAM(6, 1);

    { pg8::Gemm g{(const bf16_t*)(ws + WS_ACT), (const bf16_t*)(ws + WS_WF2), DFF, DFF, DFF, 0}; pg8::StaticOrder S; S.init(MTOK, DM, G, bx);
      for (int rep = 1; rep < REP_P3D; ++rep) { EpiFfn2 E0{(const bf16_t*)(ws + WS_X1B), (float*)(ws + WS_GATE)}; pg8::gemm_phase(scr, g, S, E0); }
      EpiFfn2 E{(const bf16_t*)(ws + WS_X1B), P.out};
      pg8::gemm_phase(scr, g, S, E); }
    SEAM(7, 0);
}

extern "C" void kernel_launch(void* const* d_in, const int* in_sizes, int n_in, void* d_out, int out_size, void* d_ws, size_t ws_size, hipStream_t stream) {
    static int grid = 0;
    if (grid == 0) {
        if (n_in != 17 || out_size != MTOK * DM || ws_size < WS_END) { fprintf(stderr, "kernel_launch: unexpected shapes (n_in %d out %d ws %zu)\n", n_in, out_size, ws_size); grid = -1; return; }
        int dev = 0, cus = 0, per_cu = 0;
        hipGetDevice(&dev);
        hipDeviceGetAttribute(&cus, hipDeviceAttributeMultiprocessorCount, dev);
        hipFuncSetAttribute((const void*)fwd_kernel, hipFuncAttributeMaxDynamicSharedMemorySize, LDS_BYTES);
        hipOccupancyMaxActiveBlocksPerMultiprocessor(&per_cu, (const void*)fwd_kernel, 512, LDS_BYTES);
        if (per_cu < 1) { fprintf(stderr, "kernel_launch: occupancy query says %d blocks per CU\n", per_cu); grid = -1; return; }
        grid = cus * (per_cu < 1 ? 0 : 1);
        fprintf(stderr, "kernel_launch: grid %d (occupancy %d per CU)\n", grid, per_cu);
    }
    if (grid < 0) return;
    Params p{};
    p.x = (const float*)d_in[0]; p.pos = (const int*)d_in[1]; p.norm1_w = (const float*)d_in[2]; p.w_in = (const float*)d_in[3]; p.b_gate = (const float*)d_in[4];
    p.q_norm_w = (const float*)d_in[5]; p.k_norm_w = (const float*)d_in[6]; p.w_o_attn = (const float*)d_in[7]; p.conv_w = (const float*)d_in[8]; p.conv_b = (const float*)d_in[9];
    p.conv_ln_w = (const float*)d_in[10]; p.conv_ln_b = (const float*)d_in[11]; p.w_pw_conv = (const float*)d_in[12]; p.w_out = (const float*)d_in[13]; p.norm2_w = (const float*)d_in[14];
    p.w_ffn_in = (const float*)d_in[15]; p.w_ffn_out = (const float*)d_in[16]; p.out = (float*)d_out; p.ws = (unsigned char*)d_ws;
    if (hipMemsetAsync((char*)d_ws + WS_CTL, 0, CTL_BYTES, stream) != hipSuccess) { fprintf(stderr, "kernel_launch: memset failed\n"); return; }
    void* args[] = {&p};
    hipError_t e = hipLaunchCooperativeKernel((const void*)fwd_kernel, dim3(grid), dim3(512), args, LDS_BYTES, stream);
    if (e != hipSuccess) fprintf(stderr, "cooperative launch failed: %s (grid %d)\n", hipGetErrorString(e), grid);
}
```
